# Optimizing an MI355X kernel written in HIP

```python
import jax, jax.numpy as jnp
from jax import lax
import numpy as np

D_MODEL = 2048
BATCH = 16
SEQ = 2048
DEPTH = 1

PLE_DIM = 256
POOL_WIDTH = D_MODEL // 2
POOL_WINDOWS = (2, 4, 8, 16)
POOL_GROUP = POOL_WIDTH // len(POOL_WINDOWS)
HEAD_DIM = 64
N_HEADS = (D_MODEL // 2) // HEAD_DIM
ATTN_WIDTH = N_HEADS * HEAD_DIM
MIX_WIDTH = POOL_WIDTH + ATTN_WIDTH
Q_BLOCK = 128
N_EXPERTS = 32
TOP_K = 4
D_EXPERT = D_MODEL
SWIGLU_LIMIT = 7.0
SWIGLU_ALPHA = 1.702
EXPERT_BLOCK = 256
EPS = 1e-6

kernel_name = 'hybrid_pool_stickbreak_moe_ple'


def rmsnorm(x, g):
    xf = x.astype(jnp.float32)
    y = xf * lax.rsqrt(jnp.mean(xf * xf, axis=-1, keepdims=True) + EPS)
    return (y * g.astype(jnp.float32)).astype(x.dtype)


def pool_mixer(u, pool_w, pool_scale):
    s = u.shape[1]
    uf = u.astype(jnp.float32)
    cs = jnp.cumsum(uf, axis=1)
    count = jnp.arange(1, s + 1, dtype=jnp.float32)[None, :, None]
    outs = []
    for g, w in enumerate(POOL_WINDOWS):
        sl = slice(g * POOL_GROUP, (g + 1) * POOL_GROUP)
        c = cs[..., sl]
        lag = jnp.pad(c[:, :-w], ((0, 0), (w, 0), (0, 0)))
        mean = (c - lag) / jnp.minimum(count, float(w))
        d = (mean - uf[..., sl]).astype(u.dtype)
        outs.append(d @ pool_w[g])
    return jnp.concatenate(outs, axis=-1) * pool_scale


def stick_breaking_attention(q, k, v, q_norm_g, k_norm_g):
    b, s = q.shape[0], q.shape[1]
    q = rmsnorm(q, q_norm_g).transpose(0, 2, 1, 3).astype(jnp.float32)
    k = rmsnorm(k, k_norm_g).transpose(0, 2, 1, 3).astype(jnp.float32)
    vf = v.transpose(0, 2, 1, 3).astype(jnp.float32)
    scale = HEAD_DIM ** -0.5
    outs = []
    for i in range(s // Q_BLOCK):
        lo, hi = i * Q_BLOCK, (i + 1) * Q_BLOCK
        z = jnp.einsum('bhqd,bhkd->bhqk', q[:, :, lo:hi], k[:, :, :hi]) * scale
        mask = jnp.arange(hi)[None, :] < jnp.arange(lo, hi)[:, None]
        log_keep = jnp.where(mask, jax.nn.log_sigmoid(-z), 0.0)
        log_pass = lax.cumsum(log_keep, axis=3, reverse=True) - log_keep
        a = jnp.where(mask, jnp.exp(jax.nn.log_sigmoid(z) + log_pass), 0.0)
        outs.append(jnp.einsum('bhqk,bhkd->bhqd', a, vf[:, :, :hi]))
    o = jnp.concatenate(outs, axis=2).astype(v.dtype)
    return o.transpose(0, 2, 1, 3).reshape(b, s, ATTN_WIDTH)


def moe(x2, router_w, router_b, w_gate_up, b_gate_up, w_down, b_down):
    t, d = x2.shape
    logits = (x2 @ router_w + router_b).astype(jnp.float32)
    top_v, top_e = lax.top_k(logits, TOP_K)
    gates = jax.nn.softmax(top_v, axis=-1)
    n = t * TOP_K
    flat_e = top_e.reshape(-1)
    flat_g = gates.reshape(-1)
    flat_tok = jnp.arange(n, dtype=jnp.int32) // TOP_K
    order = jnp.argsort(flat_e)
    se = flat_e[order]
    counts = jnp.bincount(flat_e, length=N_EXPERTS)
    starts = jnp.cumsum(counts) - counts
    pcounts = (counts + EXPERT_BLOCK - 1) // EXPERT_BLOCK * EXPERT_BLOCK
    pends = jnp.cumsum(pcounts)
    pstarts = pends - pcounts
    dest = pstarts[se] + jnp.arange(n, dtype=jnp.int32) - starts[se]
    nb = -(-n // EXPERT_BLOCK) + N_EXPERTS
    rows = nb * EXPERT_BLOCK
    buf_tok = jnp.full((rows,), t, dtype=jnp.int32).at[dest].set(flat_tok[order])
    buf_g = jnp.zeros((rows,), jnp.float32).at[dest].set(flat_g[order])
    block_e = jnp.minimum(jnp.searchsorted(pends, jnp.arange(nb, dtype=jnp.int32) * EXPERT_BLOCK, side='right'), N_EXPERTS - 1)
    x_pad = jnp.concatenate([x2, jnp.zeros((1, d), x2.dtype)], axis=0)

    def expert_block(args):
        tok, g, e = args
        xb = x_pad[tok]
        hgu = xb @ w_gate_up[e] + b_gate_up[e]
        gate = jnp.minimum(hgu[:, 0::2], SWIGLU_LIMIT)
        up = jnp.clip(hgu[:, 1::2], -SWIGLU_LIMIT, SWIGLU_LIMIT)
        act = gate * jax.nn.sigmoid(SWIGLU_ALPHA * gate) * (up + 1.0)
        out = act @ w_down[e] + b_down[e]
        return out * g[:, None].astype(out.dtype)

    out = lax.map(expert_block, (buf_tok.reshape(nb, EXPERT_BLOCK), buf_g.reshape(nb, EXPERT_BLOCK), block_e))
    y = jnp.zeros((t + 1, d), out.dtype).at[buf_tok].add(out.reshape(rows, d))
    return y[:t]


def setup_inputs(seed: int = 0) -> dict:
    key = jax.random.key(seed)
    ks = jax.random.split(key, 20)
    f32 = jnp.float32
    nrm = lambda k, shape, s: jax.random.normal(k, shape, f32) * s
    L, D, F = DEPTH, D_MODEL, D_EXPERT
    return {
        'x': nrm(ks[0], (BATCH, SEQ, D), 1.0),
        'p': nrm(ks[1], (DEPTH, BATCH, SEQ, PLE_DIM), 1.0),
        'ln_mix_g': 1.0 + nrm(ks[2], (L, D), 0.05),
        'w_in': nrm(ks[3], (L, D, POOL_WIDTH + 3 * ATTN_WIDTH), D ** -0.5),
        'pool_w': nrm(ks[4], (L, len(POOL_WINDOWS), POOL_GROUP, POOL_GROUP), POOL_GROUP ** -0.5),
        'pool_scale': 1.0 + nrm(ks[5], (L, POOL_WIDTH), 0.1),
        'q_norm_g': 1.0 + nrm(ks[6], (L, HEAD_DIM), 0.05),
        'k_norm_g': 1.0 + nrm(ks[7], (L, HEAD_DIM), 0.05),
        'w_out': nrm(ks[8], (L, MIX_WIDTH, D), MIX_WIDTH ** -0.5),
        'ln_ffn_g': 1.0 + nrm(ks[9], (L, D), 0.05),
        'router_w': nrm(ks[10], (L, D, N_EXPERTS), D ** -0.5),
        'router_b': nrm(ks[11], (L, N_EXPERTS), 0.01),
        'w_gate_up': nrm(ks[12], (L, N_EXPERTS, D, 2 * F), D ** -0.5),
        'b_gate_up': nrm(ks[13], (L, N_EXPERTS, 2 * F), 0.02),
        'w_down': nrm(ks[14], (L, N_EXPERTS, F, D), F ** -0.5),
        'b_down': nrm(ks[15], (L, N_EXPERTS, D), 0.02),
        'ln_ple_g': 1.0 + nrm(ks[16], (L, D), 0.05),
        'ple_gate_w': nrm(ks[17], (L, D, D), D ** -0.5),
        'ple_proj': nrm(ks[18], (L, PLE_DIM, D), PLE_DIM ** -0.5),
        'ple_norm_g': 1.0 + nrm(ks[19], (L, D), 0.05),
    }


def reference(x, p, ln_mix_g, w_in, pool_w, pool_scale, q_norm_g, k_norm_g, w_out, ln_ffn_g,
              router_w, router_b, w_gate_up, b_gate_up, w_down, b_down, ln_ple_g, ple_gate_w,
              ple_proj, ple_norm_g):
    b, s, d = x.shape
    h = x
    for i in range(DEPTH):
        hn = rmsnorm(h, ln_mix_g[i])
        proj = hn @ w_in[i]
        u = proj[..., :POOL_WIDTH]
        q, k, v = jnp.split(proj[..., POOL_WIDTH:], 3, axis=-1)
        q = q.reshape(b, s, N_HEADS, HEAD_DIM)
        k = k.reshape(b, s, N_HEADS, HEAD_DIM)
        v = v.reshape(b, s, N_HEADS, HEAD_DIM)
        pool_out = pool_mixer(u, pool_w[i], pool_scale[i])
        attn_out = stick_breaking_attention(q, k, v, q_norm_g[i], k_norm_g[i])
        h = h + jnp.concatenate([pool_out, attn_out], axis=-1) @ w_out[i]
        hn = rmsnorm(h, ln_ffn_g[i])
        h = h + moe(hn.reshape(b * s, d), router_w[i], router_b[i], w_gate_up[i], b_gate_up[i],
                    w_down[i], b_down[i]).reshape(b, s, d)
        gate = jax.nn.sigmoid(rmsnorm(h, ln_ple_g[i]) @ ple_gate_w[i])
        e = rmsnorm(p[i] @ ple_proj[i], ple_norm_g[i])
        h = h + gate * e
    return h
```

```cpp
#include <hip/hip_runtime.h>
#include <cstdio>
#include <cstdint>

#define GAS __attribute__((address_space(1)))
#define LAS __attribute__((address_space(3)))
typedef unsigned short bf16;
typedef short bf16x8 __attribute__((ext_vector_type(8)));
typedef float f32x4 __attribute__((ext_vector_type(4)));
typedef float f32x2 __attribute__((ext_vector_type(2)));
typedef float f32x16 __attribute__((ext_vector_type(16)));
typedef unsigned u32x4 __attribute__((ext_vector_type(4)));
typedef unsigned u32x2 __attribute__((ext_vector_type(2)));
typedef int i32x4 __attribute__((ext_vector_type(4)));
typedef int i32x8 __attribute__((ext_vector_type(8)));

#ifndef KROT_MOE
#define KROT_MOE 1
#endif
#ifndef KROT_DENSE
#define KROT_DENSE 0
#endif
#ifndef MK_ONE_LAUNCH
#define MK_ONE_LAUNCH 1
#endif

constexpr int BATCH = 16, SEQ = 2048, T = BATCH * SEQ, DM = 2048, PLE = 256, POOLW = 1024, NH = 16, HD = 64, NE = 32, FF = 2048;
constexpr int LCAP = 32768;
constexpr float EPS = 1e-6f;
constexpr float LOG2E = 1.4426950408889634f;
constexpr int NPHASE = 10;

constexpr size_t MiB = 1u << 20;
constexpr size_t WS_CTL = 0, CTL_ZERO_BYTES = 1 * MiB;
constexpr size_t WS_WINT = 2 * MiB;
constexpr size_t WS_WVT = 14 * MiB;
constexpr size_t WS_POOLT = 18 * MiB;
constexpr size_t WS_WRHI = 19 * MiB;
constexpr size_t WS_WRLO = 19 * MiB + 512 * 1024;
constexpr size_t WS_WOUTT = 20 * MiB;
constexpr size_t WS_WGATET = 28 * MiB;
constexpr size_t WS_WPROJT = 36 * MiB;
constexpr size_t WS_PBF = 38 * MiB;
constexpr size_t WS_LFLAT = 54 * MiB, WS_LGATE = 58 * MiB, WS_LRSTD = 62 * MiB;
constexpr size_t WS_SSE = 66 * MiB;
constexpr size_t WS_RSTDE = 70 * MiB;
constexpr size_t WS_HN = 72 * MiB;
constexpr size_t WS_U = 200 * MiB;
constexpr size_t WS_Q = 264 * MiB;
constexpr size_t WS_K = 328 * MiB;
constexpr size_t WS_VT = 392 * MiB;
constexpr size_t WS_DD = 456 * MiB;
constexpr size_t WS_MIX = 520 * MiB;
constexpr size_t WS_H1 = 648 * MiB;
constexpr size_t WS_XG2 = 904 * MiB;
constexpr size_t WS_ERAW = 1032 * MiB;
constexpr size_t WS_WGUT = 1160 * MiB;
constexpr size_t WS_WDT = 1672 * MiB;
constexpr size_t WS_ACT = 1928 * MiB;
constexpr size_t WS_Y4 = 2472 * MiB;
constexpr size_t WS_END = 2984 * MiB;
constexpr int CW_CNT = 64;
constexpr int CW_BAR = 4096;

constexpr int RING_BYTES = 131072;
constexpr int LDSCTL_OFF = RING_BYTES, MISC_OFF = LDSCTL_OFF + 320, TAB_OFF = LDSCTL_OFF + 1024;
constexpr int META_OFF = LDSCTL_OFF + 2048, META_SLOT = 3072;
constexpr int LDS_BYTES = 147456;

__device__ __forceinline__ unsigned cvt_pk_bf16(float lo, float hi) { unsigned r; asm volatile("v_cvt_pk_bf16_f32 %0, %1, %2" : "=v"(r) : "v"(lo), "v"(hi)); return r; }
__device__ __forceinline__ unsigned cvtpk(float lo, float hi) { typedef __bf16 bf2 __attribute__((ext_vector_type(2))); f32x2 v = {lo, hi}; bf2 b = __builtin_convertvector(v, bf2); return __builtin_bit_cast(unsigned, b); }
__device__ __forceinline__ float bf_lo(unsigned w) { return __uint_as_float(w << 16); }
__device__ __forceinline__ float bf_hi(unsigned w) { return __uint_as_float(w & 0xffff0000u); }
__device__ __forceinline__ float wave_sum(float v) {
#pragma unroll
    for (int o = 1; o < 64; o <<= 1) v += __shfl_xor(v, o);
    return v;
}
__device__ __forceinline__ u32x4 pair16(const u32x2& wa, const u32x2& wb) {
    const auto sx = __builtin_amdgcn_permlane16_swap(wa.x, wb.x, false, false); const auto sy = __builtin_amdgcn_permlane16_swap(wa.y, wb.y, false, false);
    u32x4 o; o.x = sx[0]; o.y = sy[0]; o.z = sx[1]; o.w = sy[1]; return o; }
__device__ __forceinline__ unsigned pk4_fp8(float a, float b, float c, float d) {
    a = __builtin_amdgcn_fmed3f(a, -448.f, 448.f); b = __builtin_amdgcn_fmed3f(b, -448.f, 448.f); c = __builtin_amdgcn_fmed3f(c, -448.f, 448.f); d = __builtin_amdgcn_fmed3f(d, -448.f, 448.f);
    int r = __builtin_amdgcn_cvt_pk_fp8_f32(a, b, 0, false); r = __builtin_amdgcn_cvt_pk_fp8_f32(c, d, r, true); return (unsigned)r; }
__device__ __forceinline__ unsigned pk4_fp8_nc(float a, float b, float c, float d) { int r = __builtin_amdgcn_cvt_pk_fp8_f32(a, b, 0, false); r = __builtin_amdgcn_cvt_pk_fp8_f32(c, d, r, true); return (unsigned)r; }
constexpr float SC_Y8 = 32.f;
constexpr float SC_G8 = 8.f;
constexpr float SC_X8 = 16.f, SC_W8 = 64.f, SC_A8 = 4.f;
__device__ __forceinline__ float fast_sigmoid(float x) { return __builtin_amdgcn_rcpf(1.0f + __builtin_amdgcn_exp2f(-x * LOG2E)); }

namespace pg8 {
constexpr int BM = 256, BK = 64, HALF = 128, HTB = HALF * BK * 2, STAGE_BYTES = 8 * HTB, NXCD = 8, WGM = 8;
__host__ __device__ __forceinline__ int lds_byte(int r, int c) { const int st = (r >> 4) * 2 + (c >> 5), rr = r & 15, cc = c & 31, ob = rr * 64 + cc * 2; return st * 1024 + (ob ^ (((ob >> 9) & 1) << 5)); }
__host__ __device__ __forceinline__ void stage_rc(int b, int& R, int& C) { const int st = b / 1024, sb = b % 1024, swz = sb ^ (((sb >> 9) & 1) << 5); R = (st >> 1) * 16 + swz / 64; C = (st & 1) * 32 + (swz % 64) / 2; }
__host__ __device__ __forceinline__ int perm32(int rho) { const int n = rho >> 4, i = rho & 15; return 8 * (i >> 2) + 4 * n + (i & 3); }

struct Unit { int pm, pn, e, r0, nrows, rb; };

template <class Epi, class Sched>
__device__ __forceinline__ void gemm_phase(LAS unsigned char* lds, const Sched& S, const Epi& E) {
    constexpr bool GATHER = Sched::GATHER; constexpr bool FP8 = Sched::FP8; constexpr bool META = Sched::META; constexpr bool KROT = Sched::KROT;
    const int tid = threadIdx.x, wid = __builtin_amdgcn_readfirstlane(tid >> 6), lane = tid & 63, wr = wid >> 2, wc = wid & 3, fr = lane & 15, fq = lane >> 4;
    const int K = S.K, nt = K / BK, lda = S.lda;
    unsigned voffA[2], voffB[2]; int RA[2], CA[2];
#pragma unroll
    for (int i = 0; i < 2; ++i) { int R, C; stage_rc(tid * 16 + i * 8192, R, C); const int Rb = (R & ~31) + perm32(R & 31);
        RA[i] = R; CA[i] = C; voffA[i] = (unsigned)(R * lda + C) * 2u; voffB[i] = (unsigned)(Rb * K + C) * 2u; }
    const size_t kstep = (size_t)(BK * 2);
    const size_t hstepA = (size_t)HALF * lda * 2, hstepB = (size_t)HALF * K * 2;
    const unsigned ldsw = (unsigned)wid * 1024u;
    const int aoff = lds_byte(wr * 64 + fr, fq * 8), boff = lds_byte(wc * 32 + fr, fq * 8);
#define PG8_SA(b, h) (((b) * 2 + (h)) * HTB)
#define PG8_SB(b, h) ((4 + (b) * 2 + (h)) * HTB)
#define PG8_STAGE_B(bufoff, gbase, h) do { _Pragma("unroll") for (int _i = 0; _i < 2; ++_i) \
        __builtin_amdgcn_global_load_lds((const unsigned*)((const char*)(gbase) + (h) * hstepB + voffB[_i]), (LAS unsigned*)(lds + (bufoff) + ldsw + _i * 8192), 16, 0, 0); } while (0)
#define PG8_STAGE_A(bufoff, gbase, h, og) do { _Pragma("unroll") for (int _i = 0; _i < 2; ++_i) { \
        if constexpr (GATHER) __builtin_amdgcn_global_load_lds((const unsigned*)((const char*)(gbase) + (og)[h][_i]), (LAS unsigned*)(lds + (bufoff) + ldsw + _i * 8192), 16, 0, 0); \
        else __builtin_amdgcn_global_load_lds((const unsigned*)((const char*)(gbase) + (h) * hstepA + voffA[_i]), (LAS unsigned*)(lds + (bufoff) + ldsw + _i * 8192), 16, 0, 0); } } while (0)
#define PG8_LDA(dst, b, h) do { _Pragma("unroll") for (int m = 0; m < 4; ++m) _Pragma("unroll") for (int k = 0; k < 2; ++k) dst[m][k] = *(const LAS bf16x8*)(lds + PG8_SA(b, h) + aoff + m * 2048 + k * 1024); } while (0)
#define PG8_LDB(dst, b, h) do { _Pragma("unroll") for (int n = 0; n < 2; ++n) _Pragma("unroll") for (int k = 0; k < 2; ++k) dst[n][k] = *(const LAS bf16x8*)(lds + PG8_SB(b, h) + boff + n * 2048 + k * 1024); } while (0)
#define PG8_MMA(ai, bj, At, Bt) do { __builtin_amdgcn_s_setprio(1); _Pragma("unroll") for (int m = 0; m < 4; ++m) _Pragma("unroll") for (int n = 0; n < 2; ++n) { \
        if constexpr (FP8) { const i32x8 a8 = __builtin_shufflevector(__builtin_bit_cast(i32x4, At[m][0]), __builtin_bit_cast(i32x4, At[m][1]), 0, 1, 2, 3, 4, 5, 6, 7); \
            const i32x8 b8 = __builtin_shufflevector(__builtin_bit_cast(i32x4, Bt[n][0]), __builtin_bit_cast(i32x4, Bt[n][1]), 0, 1, 2, 3, 4, 5, 6, 7); \
            asm volatile("v_mfma_f32_16x16x128_f8f6f4 %0, %1, %2, %0" : "+v"(acc[ai][bj][m][n]) : "v"(b8), "v"(a8)); } \
        else { _Pragma("unroll") for (int k = 0; k < 2; ++k) acc[ai][bj][m][n] = __builtin_amdgcn_mfma_f32_16x16x32_bf16(Bt[n][k], At[m][k], acc[ai][bj][m][n], 0, 0, 0); } } \
        __builtin_amdgcn_s_setprio(0); } while (0)
#define PG8_MMA0(ai, bj, At, Bt) do { __builtin_amdgcn_s_setprio(1); _Pragma("unroll") for (int m = 0; m < 4; ++m) _Pragma("unroll") for (int n = 0; n < 2; ++n) { \
        if constexpr (FP8) { const i32x8 a8 = __builtin_shufflevector(__builtin_bit_cast(i32x4, At[m][0]), __builtin_bit_cast(i32x4, At[m][1]), 0, 1, 2, 3, 4, 5, 6, 7); \
            const i32x8 b8 = __builtin_shufflevector(__builtin_bit_cast(i32x4, Bt[n][0]), __builtin_bit_cast(i32x4, Bt[n][1]), 0, 1, 2, 3, 4, 5, 6, 7); \
            asm volatile("v_mfma_f32_16x16x128_f8f6f4 %0, %1, %2, 0" : "=&v"(acc[ai][bj][m][n]) : "v"(b8), "v"(a8)); } \
        else { acc[ai][bj][m][n] = __builtin_amdgcn_mfma_f32_16x16x32_bf16(Bt[n][0], At[m][0], (f32x4){0.f, 0.f, 0.f, 0.f}, 0, 0, 0); \
               acc[ai][bj][m][n] = __builtin_amdgcn_mfma_f32_16x16x32_bf16(Bt[n][1], At[m][1], acc[ai][bj][m][n], 0, 0, 0); } } \
        __builtin_amdgcn_s_setprio(0); } while (0)
#define PG8_WAIT_V(n) asm volatile("s_waitcnt vmcnt(" #n ")" ::: "memory")
#define PG8_WAIT_L(n) asm volatile("s_waitcnt lgkmcnt(" #n ")" ::: "memory")
#define PG8_BAR __builtin_amdgcn_s_barrier()
#define PG8_SCHED __builtin_amdgcn_sched_barrier(0)
    Unit cur, nxt; int ui = 0;
    if (!S.next(0, cur)) return;
    f32x4 acc[2][2][4][2];
#define PG8_ZERO_ACC do { _Pragma("unroll") for (int a = 0; a < 2; ++a) _Pragma("unroll") for (int b = 0; b < 2; ++b) _Pragma("unroll") for (int m = 0; m < 4; ++m) _Pragma("unroll") for (int n = 0; n < 2; ++n) \
        acc[a][b][m][n] = (f32x4){0.f, 0.f, 0.f, 0.f}; } while (0)
    bf16x8 At[4][2], B0[2][2], B1[2][2];
    unsigned ogc[2][2] = {{0u, 0u}, {0u, 0u}}, ogn[2][2] = {{0u, 0u}, {0u, 0u}};
    LAS unsigned char* const meta = lds + META_OFF;
#define PG8_META_DMA(u, slot) do { if (wid < 4) { const int r_ = tid < (u).nrows ? tid : (u).nrows - 1; const size_t ix_ = (size_t)(u).e * LCAP + (u).r0 + r_; \
            __builtin_amdgcn_global_load_lds((const unsigned*)(S.lflat + ix_), (LAS unsigned*)(meta + (slot) * META_SLOT + wid * 256), 4, 0, 0); \
            __builtin_amdgcn_global_load_lds((const unsigned*)(S.lval + ix_), (LAS unsigned*)(meta + (slot) * META_SLOT + 1024 + wid * 256), 4, 0, 0); } \
        else if (wid == 4) __builtin_amdgcn_global_load_lds((const unsigned*)(S.bias_ptr(u) + 4 * lane), (LAS unsigned*)(meta + (slot) * META_SLOT + 2048), 16, 0, 0); } while (0)
#define PG8_META_OG(dst, slot) do { _Pragma("unroll") for (int h = 0; h < 2; ++h) _Pragma("unroll") for (int i = 0; i < 2; ++i) \
        dst[h][i] = (unsigned)(((const LAS int*)(meta + (slot) * META_SLOT))[h * HALF + RA[i]] >> 2) * (unsigned)(K * 2) + (unsigned)CA[i] * 2u; } while (0)
    int ms_cur = 0, ms_nxt = 1;
    if constexpr (META) { PG8_META_DMA(cur, 0); asm volatile("s_waitcnt vmcnt(0)" ::: "memory"); __builtin_amdgcn_s_barrier(); asm volatile("" ::: "memory");
        if constexpr (GATHER) PG8_META_OG(ogc, 0); }
    else if constexpr (GATHER) {
#pragma unroll
        for (int h = 0; h < 2; ++h)
#pragma unroll
            for (int i = 0; i < 2; ++i) ogc[h][i] = S.row_off(cur, h * HALF + RA[i]) + (unsigned)CA[i] * 2u;
    }
    const int ktm = nt - 1;
#define PG8_KOFF(k, rot) ((size_t)(((k) + (rot)) & ktm) * kstep)
    int rot_c = 0; if constexpr (KROT) rot_c = S.krot(cur, nt);
    const char* cA = S.a_base(cur); const char* cB = S.b_base(cur);
    PG8_STAGE_B(PG8_SB(0, 0), cB + PG8_KOFF(0, rot_c), 0); PG8_STAGE_B(PG8_SB(0, 1), cB + PG8_KOFF(0, rot_c), 1); PG8_STAGE_A(PG8_SA(0, 0), cA + PG8_KOFF(0, rot_c), 0, ogc); PG8_STAGE_A(PG8_SA(0, 1), cA + PG8_KOFF(0, rot_c), 1, ogc);
    if (wr == 1) PG8_BAR;
    PG8_WAIT_V(2); PG8_BAR;
    PG8_STAGE_B(PG8_SB(1, 0), cB + PG8_KOFF(1, rot_c), 0); PG8_STAGE_A(PG8_SA(1, 0), cA + PG8_KOFF(1, rot_c), 0, ogc); PG8_STAGE_B(PG8_SB(1, 1), cB + PG8_KOFF(1, rot_c), 1);
    PG8_WAIT_V(6); PG8_BAR;
    for (;;) {
        const bool has_next = S.next(ui + 1, nxt);
        const char* nA = has_next ? S.a_base(nxt) : cA; const char* nB = has_next ? S.b_base(nxt) : cB;
        int rot_n = rot_c; if constexpr (KROT) { if (has_next) rot_n = S.krot(nxt, nt); }
        if constexpr (META) { if (has_next) PG8_META_DMA(nxt, ms_nxt); }
        else if constexpr (GATHER) {
#pragma unroll
            for (int h = 0; h < 2; ++h)
#pragma unroll
                for (int i = 0; i < 2; ++i) ogn[h][i] = has_next ? S.row_off(nxt, h * HALF + RA[i]) + (unsigned)CA[i] * 2u : ogc[h][i];
        }
#define PG8_PAIR(MM0) do { \
            const bool last = (t == nt - 2); \
            if constexpr (META && GATHER) { if (t == nt - 4) { if (has_next) PG8_META_OG(ogn, ms_nxt); else { \
                    _Pragma("unroll") for (int h = 0; h < 2; ++h) _Pragma("unroll") for (int i = 0; i < 2; ++i) ogn[h][i] = ogc[h][i]; } } } \
            const char* a1 = cA + PG8_KOFF(t + 1, rot_c); \
            const char* a2 = last ? nA + PG8_KOFF(0, rot_n) : cA + PG8_KOFF(t + 2, rot_c); const char* b2 = last ? nB + PG8_KOFF(0, rot_n) : cB + PG8_KOFF(t + 2, rot_c); \
            const char* a3 = a2 + kstep; const char* b3 = b2 + kstep;            \
            unsigned og2[2][2]; \
            _Pragma("unroll") for (int h = 0; h < 2; ++h) _Pragma("unroll") for (int i = 0; i < 2; ++i) og2[h][i] = last ? ogn[h][i] : ogc[h][i]; \
              \
            PG8_LDB(B0, 0, 0); PG8_LDB(B1, 0, 1); PG8_SCHED; PG8_LDA(At, 0, 0); PG8_STAGE_A(PG8_SA(1, 1), a1, 1, ogc); \
            PG8_WAIT_V(8); PG8_WAIT_L(0); PG8_BAR; MM0(0, 0, At, B0); MM0(0, 1, At, B1); PG8_BAR; PG8_SCHED; \
              \
            PG8_LDA(At, 0, 1); PG8_STAGE_B(PG8_SB(0, 0), b2, 0); PG8_STAGE_B(PG8_SB(0, 1), b2, 1); PG8_STAGE_A(PG8_SA(0, 0), a2, 0, og2); \
            PG8_WAIT_V(8); PG8_WAIT_L(0); PG8_BAR; MM0(1, 0, At, B0); MM0(1, 1, At, B1); PG8_BAR; PG8_SCHED; \
              \
            PG8_LDB(B0, 1, 0); PG8_LDB(B1, 1, 1); PG8_SCHED; PG8_LDA(At, 1, 0); PG8_STAGE_A(PG8_SA(0, 1), a2, 1, og2); \
            PG8_WAIT_V(8); PG8_WAIT_L(0); PG8_BAR; PG8_MMA(0, 0, At, B0); PG8_MMA(0, 1, At, B1); PG8_BAR; PG8_SCHED; \
              \
            PG8_LDA(At, 1, 1); PG8_STAGE_B(PG8_SB(1, 0), b3, 0); PG8_STAGE_B(PG8_SB(1, 1), b3, 1); PG8_STAGE_A(PG8_SA(1, 0), a3, 0, og2); \
            PG8_WAIT_V(8); PG8_WAIT_L(0); PG8_BAR; PG8_MMA(1, 0, At, B0); PG8_MMA(1, 1, At, B1); PG8_BAR; PG8_SCHED; } while (0)
        if constexpr (FP8) { { const int t = 0; PG8_PAIR(PG8_MMA0); } for (int t = 2; t < nt; t += 2) PG8_PAIR(PG8_MMA); }
        else { PG8_ZERO_ACC; for (int t = 0; t < nt; t += 2) PG8_PAIR(PG8_MMA); }
#undef PG8_PAIR
        if (wr == 0) PG8_BAR;
        if constexpr (FP8) asm volatile("s_nop 15\n\ts_nop 15" ::: "memory");
        E(acc, cur, wr, wc, fr, fq, (const LAS unsigned char*)(meta + ms_cur * META_SLOT));
        if (!has_next) break;
        ms_cur = ms_nxt; ms_nxt = (ms_nxt == 2) ? 0 : ms_nxt + 1;
        cur = nxt; cA = nA; cB = nB; ++ui; rot_c = rot_n;
        if constexpr (GATHER) {
#pragma unroll
            for (int h = 0; h < 2; ++h)
#pragma unroll
                for (int i = 0; i < 2; ++i) ogc[h][i] = ogn[h][i];
        }
        if (wr == 1) PG8_BAR;
    }
    PG8_WAIT_V(0);
    PG8_BAR;
#undef PG8_KOFF
#undef PG8_META_DMA
#undef PG8_META_OG
#undef PG8_SA
#undef PG8_SB
#undef PG8_STAGE_A
#undef PG8_STAGE_B
#undef PG8_LDA
#undef PG8_LDB
#undef PG8_MMA
#undef PG8_WAIT_V
#undef PG8_WAIT_L
#undef PG8_BAR
#undef PG8_SCHED
}

template <bool FP8_> struct DenseOrderT {
    static constexpr bool GATHER = false, FP8 = FP8_, META = false, KROT = (KROT_DENSE != 0);
    __device__ __forceinline__ int krot(const Unit& u, int nt) const { return (((u.pm & 7) + 2 * (u.pn & 3)) & 7) * (nt >> 3); }
    const char* A; const char* Bt; int lda, K; int nM, nN, nwg, G, c;
    __device__ __forceinline__ void init(const void* A_, const void* Bt_, int lda_, int K_, int M, int N, int G_, int c_) { A = (const char*)A_; Bt = (const char*)Bt_; lda = lda_; K = K_; nM = M / BM; nN = N / BM; nwg = nM * nN; G = G_; c = c_; }
    __device__ __forceinline__ bool next(int i, Unit& u) const {
        const long L = (long)i * G + c; if (L >= nwg) return false;
        int wgid = (int)L; { const int q = nwg / NXCD, r = nwg % NXCD, xcd = wgid % NXCD, off = wgid / NXCD; wgid = (xcd < r ? xcd * (q + 1) : r * (q + 1) + (xcd - r) * q) + off; }
        const int nig = WGM * nN, gid = wgid / nig, fm = gid * WGM, gsz = (nM - fm) < WGM ? (nM - fm) : WGM;
        u.pm = fm + ((wgid % nig) % gsz); u.pn = (wgid % nig) / gsz; u.e = 0; u.r0 = 0; u.nrows = 256; u.rb = u.pm; return true;
    }
    __device__ __forceinline__ const char* a_base(const Unit& u) const { return A + (size_t)u.pm * BM * lda * 2; }
    __device__ __forceinline__ const char* b_base(const Unit& u) const { return Bt + (size_t)u.pn * BM * K * 2; }
    __device__ __forceinline__ unsigned row_off(const Unit&, int) const { return 0u; }
};
typedef DenseOrderT<false> DenseOrder;
struct PoolOrder {
    static constexpr bool GATHER = false, FP8 = false, META = false, KROT = false;
    const char* A; const char* Bt; int lda, K; int G, c;
    __device__ __forceinline__ bool next(int i, Unit& u) const { const int L = i * G + c; if (L >= 512) return false; u.pm = L >> 2; u.pn = L & 3; u.e = 0; u.r0 = 0; u.nrows = 256; u.rb = u.pm; return true; }
    __device__ __forceinline__ const char* a_base(const Unit& u) const { return A + ((size_t)u.pm * BM * 1024 + (size_t)u.pn * 256) * 2; }
    __device__ __forceinline__ const char* b_base(const Unit& u) const { return Bt + (size_t)u.pn * 256 * 256 * 2; }
    __device__ __forceinline__ unsigned row_off(const Unit&, int) const { return 0u; }
};
template <int NT, bool GATHER_>
struct MoeOrder {
    static constexpr bool GATHER = GATHER_, FP8 = true, META = true, KROT = (KROT_MOE != 0) && !GATHER_;
    __device__ __forceinline__ int krot(const Unit& u, int nt) const { return (((u.rb & 7) + 2 * (u.pn & 3)) & 7) * (nt >> 3); }
    const char* A; const char* Bt; int lda, K; int G, c; const LAS int* tab; const int* lflat; const float* lval; const float* bias;
    __device__ __forceinline__ const float* bias_ptr(const Unit& u) const { return bias + (size_t)u.e * (NT * 256) + u.pn * 256; }
    __device__ __forceinline__ bool next(int i, Unit& u) const {
        const int nblk = tab[32];
        const int L = i * G + c; int rb, pn;
        if (G == 256) { const int rd = L >> 8, cc = L & 255, xcd = cc & 7, j = cc >> 3;
            if (NT == 16) { rb = rd * 16 + (xcd & 1) * 8 + (j & 7); pn = (xcd >> 1) * 4 + (j >> 3); } else { rb = rd * 32 + xcd * 4 + (j & 3); pn = j >> 2; } }
        else { rb = L / NT; pn = L % NT; }
        if (rb >= nblk) return false;
        const int ln = (int)(threadIdx.x & 63); const int tv = tab[ln < 32 ? ln : ln + 8];
        const int e = __builtin_popcountll(__builtin_amdgcn_ballot_w64(ln < 32 && tv <= rb)) - 1;
        const int r0 = (rb - __builtin_amdgcn_readlane(tv, e)) * 256; int nr = __builtin_amdgcn_readlane(tv, 32 + e) - r0; nr = nr > 256 ? 256 : nr;
        u.pm = rb; u.pn = pn; u.e = e; u.r0 = r0; u.nrows = nr; u.rb = rb; return true;
    }
    __device__ __forceinline__ const char* a_base(const Unit& u) const { return GATHER ? A : A + (size_t)u.rb * BM * lda * 2; }
    __device__ __forceinline__ const char* b_base(const Unit& u) const { return Bt + ((size_t)u.e * (NT * 256) + (size_t)u.pn * 256) * K * 2; }
    __device__ __forceinline__ unsigned row_off(const Unit& u, int r) const { const int fl = lflat[u.e * LCAP + u.r0 + ((r < u.nrows) ? r : 0)]; return (unsigned)(fl >> 2) * (unsigned)(K * 2); }
};

#define EPI_ROWS(ai, m) (ai * HALF + wr * 64 + m * 16 + fr)
struct EpiInProj {
    bf16* U; bf16* Q; bf16* Kb; const float* qg; const float* kg;
    __device__ __forceinline__ void operator()(const f32x4 (&acc)[2][2][4][2], const Unit& u, int wr, int wc, int fr, int fq, const LAS unsigned char* ms) const {
        const int row0 = u.pm * BM;
        if (u.pn < 4) {
            const int col0 = u.pn * BM + wc * 32 + 8 * fq;
#pragma unroll
            for (int ai = 0; ai < 2; ++ai)
#pragma unroll
                for (int m = 0; m < 4; ++m) { bf16* rowp = U + (size_t)(row0 + EPI_ROWS(ai, m)) * POOLW + col0;
#pragma unroll
                    for (int bj = 0; bj < 2; ++bj) { const f32x4 v0 = acc[ai][bj][m][0], v1 = acc[ai][bj][m][1];
                        u32x4 w; w.x = cvt_pk_bf16(v0[0], v0[1]); w.y = cvt_pk_bf16(v0[2], v0[3]); w.z = cvt_pk_bf16(v1[0], v1[1]); w.w = cvt_pk_bf16(v1[2], v1[3]);
                        *(u32x4*)(rowp + bj * HALF) = w; } }
        } else {
            const bool isq = u.pn < 8; const int tile = isq ? u.pn - 4 : u.pn - 8; bf16* O = isq ? Q : Kb; const float* g = isq ? qg : kg; const float sc = isq ? 0.125f * LOG2E : 1.0f;
            const int head = tile * 4 + wc;
            f32x4 gv[2][2];
#pragma unroll
            for (int bj = 0; bj < 2; ++bj)
#pragma unroll
                for (int n = 0; n < 2; ++n) gv[bj][n] = *(const f32x4*)(g + 32 * bj + 8 * fq + 4 * n) * sc;
#pragma unroll
            for (int ai = 0; ai < 2; ++ai)
#pragma unroll
                for (int m = 0; m < 4; ++m) {
                    float ss = 0.f;
#pragma unroll
                    for (int bj = 0; bj < 2; ++bj)
#pragma unroll
                        for (int n = 0; n < 2; ++n) { const f32x4 v = acc[ai][bj][m][n]; ss += (v[0] * v[0] + v[1] * v[1]) + (v[2] * v[2] + v[3] * v[3]); }
                    ss += __shfl_xor(ss, 16); ss += __shfl_xor(ss, 32);
                    const float rstd = __builtin_amdgcn_rsqf(ss * (1.0f / 64.0f) + EPS);
                    bf16* rowp = O + (size_t)(row0 + EPI_ROWS(ai, m)) * 1024 + head * 64 + 8 * fq;
#pragma unroll
                    for (int bj = 0; bj < 2; ++bj) { const f32x4 v0 = acc[ai][bj][m][0] * rstd * gv[bj][0], v1 = acc[ai][bj][m][1] * rstd * gv[bj][1];
                        u32x4 w; w.x = cvt_pk_bf16(v0[0], v0[1]); w.y = cvt_pk_bf16(v0[2], v0[3]); w.z = cvt_pk_bf16(v1[0], v1[1]); w.w = cvt_pk_bf16(v1[2], v1[3]);
                        *(u32x4*)(rowp + 32 * bj) = w; }
                }
        }
    }
};
struct EpiPlain {
    bf16* O; int ldc; const float* scale; int colmul;
    __device__ __forceinline__ void operator()(const f32x4 (&acc)[2][2][4][2], const Unit& u, int wr, int wc, int fr, int fq, const LAS unsigned char* ms) const {
        const int row0 = u.pm * BM, col0 = u.pn * BM + wc * 32 + 8 * fq;
        f32x4 sv[2][2];
#pragma unroll
        for (int bj = 0; bj < 2; ++bj)
#pragma unroll
            for (int n = 0; n < 2; ++n) sv[bj][n] = scale ? *(const f32x4*)(scale + col0 + bj * HALF + 4 * n) : (f32x4){1.f, 1.f, 1.f, 1.f};
#pragma unroll
        for (int ai = 0; ai < 2; ++ai)
#pragma unroll
            for (int m = 0; m < 4; ++m) { bf16* rowp = O + (size_t)(row0 + EPI_ROWS(ai, m)) * ldc + col0;
#pragma unroll
                for (int bj = 0; bj < 2; ++bj) { const f32x4 v0 = acc[ai][bj][m][0] * sv[bj][0], v1 = acc[ai][bj][m][1] * sv[bj][1];
                    u32x4 w; w.x = cvt_pk_bf16(v0[0], v0[1]); w.y = cvt_pk_bf16(v0[2], v0[3]); w.z = cvt_pk_bf16(v1[0], v1[1]); w.w = cvt_pk_bf16(v1[2], v1[3]);
                    *(u32x4*)(rowp + bj * HALF) = w; } }
    }
};
struct EpiE {
    bf16* O; float* sse;
    __device__ __forceinline__ void operator()(const f32x4 (&acc)[2][2][4][2], const Unit& u, int wr, int wc, int fr, int fq, const LAS unsigned char* ms) const {
        const int row0 = u.pm * BM, col0 = u.pn * BM + wc * 32 + 8 * fq;
#pragma unroll
        for (int ai = 0; ai < 2; ++ai)
#pragma unroll
            for (int m = 0; m < 4; ++m) { const int row = row0 + EPI_ROWS(ai, m); bf16* rowp = O + (size_t)row * DM + col0; float ss = 0.f;
#pragma unroll
                for (int bj = 0; bj < 2; ++bj) { const f32x4 v0 = acc[ai][bj][m][0], v1 = acc[ai][bj][m][1];
                    ss += (v0[0] * v0[0] + v0[1] * v0[1]) + (v0[2] * v0[2] + v0[3] * v0[3]) + (v1[0] * v1[0] + v1[1] * v1[1]) + (v1[2] * v1[2] + v1[3] * v1[3]);
                    u32x4 w; w.x = cvt_pk_bf16(v0[0], v0[1]); w.y = cvt_pk_bf16(v0[2], v0[3]); w.z = cvt_pk_bf16(v1[0], v1[1]); w.w = cvt_pk_bf16(v1[2], v1[3]);
                    *(u32x4*)(rowp + bj * HALF) = w; }
                ss += __shfl_xor(ss, 16); ss += __shfl_xor(ss, 32);
                if (fq == 0) sse[(size_t)row * 32 + u.pn * 4 + wc] = ss; }
    }
};
struct EpiWout {
    const float* x; bf16* H1; unsigned char* XG; const float* g;
    __device__ __forceinline__ void operator()(const f32x4 (&acc)[2][2][4][2], const Unit& u, int wr, int wc, int fr, int fq, const LAS unsigned char* ms) const {
        const int row0 = u.pm * BM, col0 = u.pn * BM + wc * 32 + 8 * fq;
        f32x4 gv[2][2];
#pragma unroll
        for (int bj = 0; bj < 2; ++bj)
#pragma unroll
            for (int n = 0; n < 2; ++n) gv[bj][n] = *(const f32x4*)(g + col0 + bj * HALF + 4 * n) * SC_X8;
#pragma unroll
        for (int am = 0; am < 4; ++am) { const int ai = am >> 1;
            f32x4 xv[2][2][2];
#pragma unroll
            for (int mm = 0; mm < 2; ++mm) { const int m = 2 * (am & 1) + mm; const size_t off = (size_t)(row0 + EPI_ROWS(ai, m)) * DM + col0;
#pragma unroll
                for (int bj = 0; bj < 2; ++bj) { xv[mm][bj][0] = *(const f32x4*)(x + off + bj * HALF); xv[mm][bj][1] = *(const f32x4*)(x + off + bj * HALF + 4); } }
#pragma unroll
            for (int mm = 0; mm < 2; ++mm) { const int m = 2 * (am & 1) + mm; const size_t off = (size_t)(row0 + EPI_ROWS(ai, m)) * DM + col0;
#pragma unroll
                for (int bj = 0; bj < 2; ++bj) { const f32x4 h0 = xv[mm][bj][0] + acc[ai][bj][m][0], h1 = xv[mm][bj][1] + acc[ai][bj][m][1];
                    { u32x4 hw; hw.x = cvt_pk_bf16(h0[0], h0[1]); hw.y = cvt_pk_bf16(h0[2], h0[3]); hw.z = cvt_pk_bf16(h1[0], h1[1]); hw.w = cvt_pk_bf16(h1[2], h1[3]); *(u32x4*)(H1 + off + bj * HALF) = hw; }
                    const f32x4 v0 = h0 * gv[bj][0], v1 = h1 * gv[bj][1];
                    u32x2 w; w.x = pk4_fp8(v0[0], v0[1], v0[2], v0[3]); w.y = pk4_fp8(v1[0], v1[1], v1[2], v1[3]);
                    *(u32x2*)(XG + off + bj * HALF) = w; } }
            asm volatile("" ::: "memory"); }
    }
};
struct EpiGU {
    unsigned char* ACT;
    __device__ __forceinline__ void operator()(const f32x4 (&acc)[2][2][4][2], const Unit& u, int wr, int wc, int fr, int fq, const LAS unsigned char* ms) const {
        const int q = 4 * wc + fq;
        const LAS float* mval = (const LAS float*)(ms + 1024); const LAS float* mbias = (const LAS float*)(ms + 2048);
        f32x2 bg[2][2], bu[2][2];
#pragma unroll
        for (int bj = 0; bj < 2; ++bj)
#pragma unroll
            for (int n = 0; n < 2; ++n) { const f32x4 b = *(const LAS f32x4*)(mbias + 16 * q + 8 * bj + 4 * n); bg[bj][n] = (f32x2){b[0], b[2]}; bu[bj][n] = (f32x2){b[1], b[3]}; }
        u32x2 wv[2]; const unsigned lane_off = (unsigned)((wr * 64 + fr + 16 * (fq & 1)) * FF + 8 * (q & ~1));
#pragma unroll
        for (int ai = 0; ai < 2; ++ai)
#pragma unroll
            for (int m = 0; m < 4; ++m) { const int r = EPI_ROWS(ai, m); const bool valid = r < u.nrows; const float rs = valid ? mval[r] * (1.0f / (SC_X8 * SC_W8)) : 0.f;
                f32x2 o[4];
#pragma unroll
                for (int bj = 0; bj < 2; ++bj)
#pragma unroll
                    for (int n = 0; n < 2; ++n) { const f32x4 a = acc[ai][bj][m][n];
                        f32x2 g = (f32x2){a[0], a[1]} * rs + bg[bj][n], up = (f32x2){a[2], a[3]} * rs + bu[bj][n];
                        g = (f32x2){__builtin_fminf(g[0], 7.0f), __builtin_fminf(g[1], 7.0f)};
                        up = (f32x2){__builtin_amdgcn_fmed3f(up[0], -7.0f, 7.0f), __builtin_amdgcn_fmed3f(up[1], -7.0f, 7.0f)};
                        const f32x2 xa = g * (-1.702f * LOG2E);
                        const f32x2 d = (f32x2){__builtin_amdgcn_exp2f(xa[0]), __builtin_amdgcn_exp2f(xa[1])} + 1.0f;
                        const f32x2 t = g * (f32x2){__builtin_amdgcn_rcpf(d[0]), __builtin_amdgcn_rcpf(d[1])};
                        o[2 * bj + n] = t * (up * SC_A8 + SC_A8); }
                wv[m & 1].x = pk4_fp8_nc(o[0][0], o[0][1], o[1][0], o[1][1]); wv[m & 1].y = pk4_fp8_nc(o[2][0], o[2][1], o[3][0], o[3][1]);
                if (m & 1)
                    *(u32x4*)(ACT + ((size_t)(u.rb * BM + ai * HALF + (m - 1) * 16) * FF + u.pn * HALF) + lane_off) = pair16(wv[0], wv[1]); }
    }
};
struct EpiDown {
    unsigned char* Y4;
    __device__ __forceinline__ void operator()(const f32x4 (&acc)[2][2][4][2], const Unit& u, int wr, int wc, int fr, int fq, const LAS unsigned char* ms) const {
        const int col0 = u.pn * BM + wc * 32 + 8 * fq;
        const LAS int* mflat = (const LAS int*)ms; const LAS float* mval = (const LAS float*)(ms + 1024); const LAS float* mbias = (const LAS float*)(ms + 2048);
        f32x4 bv[2][2];
#pragma unroll
        for (int bj = 0; bj < 2; ++bj)
#pragma unroll
            for (int n = 0; n < 2; ++n) bv[bj][n] = *(const LAS f32x4*)(mbias + wc * 32 + 8 * fq + bj * HALF + 4 * n);
#pragma unroll
        for (int ai = 0; ai < 2; ++ai)
#pragma unroll
            for (int m = 0; m < 4; ++m) { const int r = EPI_ROWS(ai, m); const bool valid = r < u.nrows;
                const float gt = mval[r]; const int fl = mflat[r];
                unsigned char* rowp = Y4 + (size_t)fl * DM + col0 + ((fq & 1) ? (HALF - 8) : 0); const float gs = gt * SC_Y8;
                u32x2 w[2];
#pragma unroll
                for (int bj = 0; bj < 2; ++bj) { const f32x4 v0 = (acc[ai][bj][m][0] * (1.0f / (SC_A8 * SC_W8)) + bv[bj][0]) * gs, v1 = (acc[ai][bj][m][1] * (1.0f / (SC_A8 * SC_W8)) + bv[bj][1]) * gs;
                    w[bj].x = pk4_fp8(v0[0], v0[1], v0[2], v0[3]); w[bj].y = pk4_fp8(v1[0], v1[1], v1[2], v1[3]); }
                const u32x4 o = pair16(w[0], w[1]);
                if (valid) *(u32x4*)rowp = o; }
    }
};
struct EpiGate {
    const bf16* H2; const bf16* ER; const float* rstde; const float* gn; float* out;
    __device__ __forceinline__ void operator()(const f32x4 (&acc)[2][2][4][2], const Unit& u, int wr, int wc, int fr, int fq, const LAS unsigned char* ms) const {
        const int row0 = u.pm * BM, col0 = u.pn * BM + wc * 32 + 8 * fq;
        f32x4 gv[2][2];
#pragma unroll
        for (int bj = 0; bj < 2; ++bj)
#pragma unroll
            for (int n = 0; n < 2; ++n) gv[bj][n] = *(const f32x4*)(gn + col0 + bj * HALF + 4 * n);
#pragma unroll
        for (int am = 0; am < 4; ++am) { const int ai = am >> 1;
            u32x4 hv[2][2], ev[2][2]; float rsv[2];
#pragma unroll
            for (int mm = 0; mm < 2; ++mm) { const int m = 2 * (am & 1) + mm; const int row = row0 + EPI_ROWS(ai, m); const size_t off = (size_t)row * DM + col0; rsv[mm] = rstde[row];
#pragma unroll
                for (int bj = 0; bj < 2; ++bj) { hv[mm][bj] = *(const u32x4*)(H2 + off + bj * HALF); ev[mm][bj] = *(const u32x4*)(ER + off + bj * HALF); } }
#pragma unroll
            for (int mm = 0; mm < 2; ++mm) { const int m = 2 * (am & 1) + mm; const int row = row0 + EPI_ROWS(ai, m); const size_t off = (size_t)row * DM + col0; const float rs = rsv[mm];
#pragma unroll
                for (int bj = 0; bj < 2; ++bj) { const u32x4 hh = hv[mm][bj], er = ev[mm][bj];
                    const f32x4 h0 = {bf_lo(hh.x), bf_hi(hh.x), bf_lo(hh.y), bf_hi(hh.y)}, h1 = {bf_lo(hh.z), bf_hi(hh.z), bf_lo(hh.w), bf_hi(hh.w)};
                    const f32x4 e0 = (f32x4){bf_lo(er.x), bf_hi(er.x), bf_lo(er.y), bf_hi(er.y)} * rs * gv[bj][0], e1 = (f32x4){bf_lo(er.z), bf_hi(er.z), bf_lo(er.w), bf_hi(er.w)} * rs * gv[bj][1];
                    const f32x4 a0 = acc[ai][bj][m][0] * (1.0f / (SC_G8 * SC_W8)), a1 = acc[ai][bj][m][1] * (1.0f / (SC_G8 * SC_W8));
                    f32x4 o0, o1;
#pragma unroll
                    for (int j = 0; j < 4; ++j) { o0[j] = h0[j] + fast_sigmoid(a0[j]) * e0[j]; o1[j] = h1[j] + fast_sigmoid(a1[j]) * e1[j]; }
                    *(f32x4*)(out + off + bj * HALF) = o0; *(f32x4*)(out + off + bj * HALF + 4) = o1; } }
            asm volatile("" ::: "memory"); }
    }
};
#undef EPI_ROWS
}

#define XB_TMO      128
#define XB_XCNT(j)  (256  + 64 * (j))
#define XB_XSUB(j)  (1280 + 64 * (j))
#define XB_XGEN(j)  (2304 + 64 * (j))
#define XB_TOP      3328
#define XB_TOPGEN   3392
#define XCD_BAR_WORDS 3456
#define XB_SPIN_CAP (1u << 18)
__device__ __forceinline__ unsigned xb_ld(unsigned* p)              { return __hip_atomic_load(p, __ATOMIC_RELAXED, __HIP_MEMORY_SCOPE_AGENT); }
__device__ __forceinline__ unsigned xb_add(unsigned* p, unsigned v) { return __hip_atomic_fetch_add(p, v, __ATOMIC_RELAXED, __HIP_MEMORY_SCOPE_AGENT); }
__device__ __forceinline__ unsigned xb_xcc_id() { return (unsigned)__builtin_amdgcn_s_getreg((3 << 11) | 20) & 0xFu; }
#define XB_SPIN(cond, bar) do { unsigned _sp = 0; while (cond) { __builtin_amdgcn_s_sleep(1); \
    if ((++_sp & 255u) == 0u) { if (xb_ld(&(bar)[XB_TMO])) break; if (_sp > XB_SPIN_CAP) { atomicAdd(&(bar)[XB_TMO], 1u); break; } } } } while (0)
struct XcdBarrier { unsigned* bar; unsigned x; volatile LAS unsigned* st; };
__device__ __forceinline__ XcdBarrier xcd_barrier_post(unsigned* bar, volatile LAS unsigned* st) {
    XcdBarrier b; b.bar = bar; b.x = xb_xcc_id(); b.st = st;
    if (threadIdx.x == 0) (void)xb_add(&bar[XB_XCNT(b.x)], 1u);
    return b;
}
__device__ __forceinline__ void xcd_barrier_complete(unsigned* bar, unsigned x, unsigned& nloc, unsigned& nx) {
    const unsigned G = gridDim.x * gridDim.y * gridDim.z;
    unsigned sum, cnt, mine, sp = 0u;
    for (;;) {
        sum = 0u; cnt = 0u; mine = 0u;
#pragma unroll
        for (unsigned j = 0; j < 16; ++j) { const unsigned c = xb_ld(&bar[XB_XCNT(j)]); sum += c; cnt += (c > 0u) ? 1u : 0u; mine = (j == x) ? c : mine; }
        if (sum == G) break;
        __builtin_amdgcn_s_sleep(1);
        if ((++sp & 255u) == 0u) { if (xb_ld(&bar[XB_TMO])) break; if (sp > XB_SPIN_CAP) { atomicAdd(&bar[XB_TMO], 1u); break; } }
    }
    nloc = mine > 0u ? mine : 1u; nx = cnt > 0u ? cnt : 1u;
}
__device__ __forceinline__ void xcd_barrier(const XcdBarrier& b) {
    asm volatile("s_waitcnt vmcnt(0)" ::: "memory");
    __syncthreads();
    if (threadIdx.x == 0) {
        unsigned* bar = b.bar;
        __builtin_amdgcn_s_waitcnt(0);
        unsigned nloc = b.st[0], nx = b.st[1];
        if (nloc == 0u) { xcd_barrier_complete(bar, b.x, nloc, nx); b.st[0] = nloc; b.st[1] = nx; }
        const unsigned old = xb_add(&bar[XB_XSUB(b.x)], 1u);
        const unsigned gen = old / nloc;
        if (old + 1u == (gen + 1u) * nloc) {
            __builtin_amdgcn_fence(__ATOMIC_RELEASE, "agent");
            asm volatile("s_waitcnt vmcnt(0)" ::: "memory");
            const unsigned og = xb_add(&bar[XB_TOP], 1u);
            const unsigned tg = og / nx;
            if (og + 1u == (tg + 1u) * nx) xb_add(&bar[XB_TOPGEN], 1u);
            else XB_SPIN(xb_ld(&bar[XB_TOPGEN]) == tg, bar);
            __builtin_amdgcn_fence(__ATOMIC_ACQUIRE, "agent");
            xb_add(&bar[XB_XGEN(b.x)], 1u);
            asm volatile("s_waitcnt vmcnt(0)" ::: "memory");
        } else {
            XB_SPIN(xb_ld(&bar[XB_XGEN(b.x)]) == gen, bar);
            __builtin_amdgcn_fence(__ATOMIC_ACQUIRE, "agent");
            asm volatile("s_waitcnt vmcnt(0)" ::: "memory");
        }
    }
    __syncthreads();
}

__device__ __forceinline__ unsigned f2bf(float f) { unsigned u = __builtin_bit_cast(unsigned, f); return (u + 0x7fffu + ((u >> 16) & 1u)) >> 16; }
__device__ __forceinline__ unsigned pk2(float lo, float hi) { return f2bf(lo) | (f2bf(hi) << 16); }
__device__ __forceinline__ void tr_item(const float* W, int N, bf16* dstrow0, int K, int k0, int n0, LAS float* scr, int lane) {
    { float v_[32]; const float* wp_ = W + (size_t)(k0 + (lane >> 5)) * N + n0 + (lane & 31);
#pragma unroll
      for (int i = 0; i < 32; ++i) v_[i] = wp_[(size_t)(2 * i) * N];
#pragma unroll
      for (int i = 0; i < 32; ++i) scr[(2 * i + (lane >> 5)) * 33 + (lane & 31)] = v_[i]; }
    asm volatile("s_waitcnt lgkmcnt(0)" ::: "memory");
    const int c = lane & 7;
#pragma unroll
    for (int j = 0; j < 4; ++j) { const int n = (lane >> 3) + 8 * j; const LAS float* s = scr + (8 * c) * 33 + n;
        u32x4 o; o.x = pk2(s[0 * 33], s[1 * 33]); o.y = pk2(s[2 * 33], s[3 * 33]); o.z = pk2(s[4 * 33], s[5 * 33]); o.w = pk2(s[6 * 33], s[7 * 33]);
        *(u32x4*)(dstrow0 + (size_t)n * K + k0 + 8 * c) = o; }
    asm volatile("s_waitcnt lgkmcnt(0)" ::: "memory");
}

template <class RowMap>
__device__ __forceinline__ void tr_item_fp8(const float* W, int N, unsigned char* dst, int Kb, int k0, int n0, float scale, const RowMap& rowmap, LAS float* scr, int lane) {
    { float v_[32]; const float* wp_ = W + (size_t)(k0 + (lane >> 5)) * N + n0 + (lane & 31);
#pragma unroll
      for (int i = 0; i < 32; ++i) v_[i] = wp_[(size_t)(2 * i) * N];
#pragma unroll
      for (int i = 0; i < 32; ++i) scr[(2 * i + (lane >> 5)) * 33 + (lane & 31)] = v_[i]; }
    asm volatile("s_waitcnt lgkmcnt(0)" ::: "memory");
    const int n = lane >> 1, hf = lane & 1; const LAS float* sp = scr + (32 * hf) * 33 + n;
    u32x4 o0, o1;
    o0.x = pk4_fp8(sp[0 * 33] * scale, sp[1 * 33] * scale, sp[2 * 33] * scale, sp[3 * 33] * scale);     o0.y = pk4_fp8(sp[4 * 33] * scale, sp[5 * 33] * scale, sp[6 * 33] * scale, sp[7 * 33] * scale);
    o0.z = pk4_fp8(sp[8 * 33] * scale, sp[9 * 33] * scale, sp[10 * 33] * scale, sp[11 * 33] * scale);   o0.w = pk4_fp8(sp[12 * 33] * scale, sp[13 * 33] * scale, sp[14 * 33] * scale, sp[15 * 33] * scale);
    o1.x = pk4_fp8(sp[16 * 33] * scale, sp[17 * 33] * scale, sp[18 * 33] * scale, sp[19 * 33] * scale); o1.y = pk4_fp8(sp[20 * 33] * scale, sp[21 * 33] * scale, sp[22 * 33] * scale, sp[23 * 33] * scale);
    o1.z = pk4_fp8(sp[24 * 33] * scale, sp[25 * 33] * scale, sp[26 * 33] * scale, sp[27 * 33] * scale); o1.w = pk4_fp8(sp[28 * 33] * scale, sp[29 * 33] * scale, sp[30 * 33] * scale, sp[31 * 33] * scale);
    unsigned char* d = dst + (size_t)rowmap(n) * Kb + k0 + 32 * hf;
    *(u32x4*)d = o0; *(u32x4*)(d + 16) = o1;
    asm volatile("s_waitcnt lgkmcnt(0)" ::: "memory");
}

template <bool GUPERM>
__device__ __forceinline__ void conv_task2(const float* W, int N, unsigned char* dst, int k0, int n0, int lane) {
    const float* src = W + (size_t)k0 * N + n0 + lane;
    const int n = n0 + lane; int row = n;
    if (GUPERM) { const int hl = n & 255, q = hl >> 4, i16 = hl & 15; row = (n & ~255) + 128 * (i16 >> 3) + 32 * (q >> 2) + 8 * (q & 3) + (i16 & 4) + ((i16 & 1) << 1) + ((i16 >> 1) & 1); }
    unsigned char* d = dst + (size_t)row * 2048 + k0;
#pragma unroll
    for (int hf = 0; hf < 2; ++hf) { float v[64];
#pragma unroll
        for (int k = 0; k < 64; ++k) v[k] = src[(size_t)(64 * hf + k) * N];
#pragma unroll
        for (int c = 0; c < 4; ++c) { u32x4 o;
            o.x = pk4_fp8(v[16 * c + 0] * SC_W8, v[16 * c + 1] * SC_W8, v[16 * c + 2] * SC_W8, v[16 * c + 3] * SC_W8);   o.y = pk4_fp8(v[16 * c + 4] * SC_W8, v[16 * c + 5] * SC_W8, v[16 * c + 6] * SC_W8, v[16 * c + 7] * SC_W8);
            o.z = pk4_fp8(v[16 * c + 8] * SC_W8, v[16 * c + 9] * SC_W8, v[16 * c + 10] * SC_W8, v[16 * c + 11] * SC_W8); o.w = pk4_fp8(v[16 * c + 12] * SC_W8, v[16 * c + 13] * SC_W8, v[16 * c + 14] * SC_W8, v[16 * c + 15] * SC_W8);
            *(u32x4*)(d + 64 * hf + 16 * c) = o; } }
}

struct Args { const float* in[20]; float* out; unsigned char* ws; int ph_lo, ph_hi; };

__device__ __forceinline__ int crow(int r, int hi) { return (r & 3) + 8 * (r >> 2) + 4 * hi; }
template <bool DIAG>
__device__ __forceinline__ void attn_block_scores(const bf16x8 (&kf)[4], const bf16x8 (&qf)[4], const bf16x8 (&tri)[2], int r32, int hi, float& carry, u32x4& p0, u32x4& p1) {
    f32x16 z = {};
#pragma unroll
    for (int ks = 0; ks < 4; ++ks) z = __builtin_amdgcn_mfma_f32_32x32x16_bf16(kf[ks], qf[ks], z, 0, 0, 0);
#pragma unroll
    for (int r = 0; r < 16; ++r) z[r] = (DIAG && crow(r, hi) >= r32) ? -1.0e30f : z[r];
    float lk[16]; float tot = 0.f;
#pragma unroll
    for (int r = 0; r < 16; ++r) { const float e = __builtin_amdgcn_exp2f(-__builtin_fabsf(z[r])); const float sp = __builtin_fmaxf(z[r], 0.f) + __builtin_amdgcn_logf(1.0f + e);
        lk[r] = -sp; z[r] = z[r] - sp; tot -= sp; }
    u32x4 l0, l1; l0.x = cvtpk(lk[0], lk[1]); l0.y = cvtpk(lk[2], lk[3]); l0.z = cvtpk(lk[4], lk[5]); l0.w = cvtpk(lk[6], lk[7]);
    l1.x = cvtpk(lk[8], lk[9]); l1.y = cvtpk(lk[10], lk[11]); l1.z = cvtpk(lk[12], lk[13]); l1.w = cvtpk(lk[14], lk[15]);
    f32x16 lp = {};
    lp = __builtin_amdgcn_mfma_f32_32x32x16_bf16(tri[0], __builtin_bit_cast(bf16x8, l0), lp, 0, 0, 0);
    lp = __builtin_amdgcn_mfma_f32_32x32x16_bf16(tri[1], __builtin_bit_cast(bf16x8, l1), lp, 0, 0, 0);
    { auto rr = __builtin_amdgcn_permlane32_swap(__float_as_uint(tot), __float_as_uint(tot), false, false); tot = __uint_as_float(rr[0]) + __uint_as_float(rr[1]); }
    float p[16];
#pragma unroll
    for (int r = 0; r < 16; ++r) p[r] = __builtin_amdgcn_exp2f(z[r] + carry + lp[r]);
    carry += tot;
    p0.x = cvtpk(p[0], p[1]); p0.y = cvtpk(p[2], p[3]); p0.z = cvtpk(p[4], p[5]); p0.w = cvtpk(p[6], p[7]);
    p1.x = cvtpk(p[8], p[9]); p1.y = cvtpk(p[10], p[11]); p1.z = cvtpk(p[12], p[13]); p1.w = cvtpk(p[14], p[15]);
}
__device__ __forceinline__ void attn_wave_pair(LAS unsigned char* lw, const bf16* Q, const bf16* Kg, const bf16* VT, bf16* MIX, int b, int h, int jp, const bf16x8 (&tri)[2]) {
    const int lane = threadIdx.x & 63, r32 = lane & 31, hi = lane >> 5;
    const int jA = 2 * jp + 1, jB = 2 * jp;
    unsigned koff[4];
#pragma unroll
    for (int i_ = 0; i_ < 4; ++i_) { const int rs_ = lane >> 3, key_ = (i_ << 2) | (rs_ >> 1) | ((rs_ & 1) << 4), c_ = (lane & 7) ^ (key_ & 7); koff[i_] = (unsigned)(key_ * 1024 + c_ * 8); }
    const bf16* ksrc = Kg + (size_t)b * SEQ * 1024 + h * 64;
    const int kfb = ((r32 >> 2) & 3) * 1024 + ((((r32 & 3) << 1) | (r32 >> 4)) * 128);
    const bf16* vsrc = VT + ((size_t)h * 64 + (lane >> 2)) * T + (size_t)b * SEQ + (((lane & 3) ^ ((lane >> 4) & 3)) * 8);
#define ATT_DMA(kb, buf) do { _Pragma("unroll") for (int i_ = 0; i_ < 4; ++i_) { \
        __builtin_amdgcn_global_load_lds((const unsigned*)(ksrc + (size_t)(kb) * 32 * 1024 + koff[i_]), (LAS unsigned*)(lw + (buf) * 8192 + i_ * 1024), 16, 0, 0); \
        __builtin_amdgcn_global_load_lds((const unsigned*)(vsrc + (size_t)(kb) * 32 + (size_t)(16 * i_) * T), (LAS unsigned*)(lw + (buf) * 8192 + 4096 + i_ * 1024), 16, 0, 0); } } while (0)
    ATT_DMA(jA, 0);
    bf16x8 qfA[4], qfB[4];
#pragma unroll
    for (int ks = 0; ks < 4; ++ks) { qfA[ks] = *(const bf16x8*)(Q + ((size_t)b * SEQ + 32 * jA + r32) * 1024 + h * 64 + 16 * ks + 8 * hi);
                                     qfB[ks] = *(const bf16x8*)(Q + ((size_t)b * SEQ + 32 * jB + r32) * 1024 + h * 64 + 16 * ks + 8 * hi); }
    f32x16 oA0 = {}, oA1 = {}, oB0 = {}, oB1 = {};
    float carryA = 0.f, carryB = 0.f; bool liveA = true, liveB = true;
    int cur = 0;
    for (int kb = jA; kb >= 0; --kb) {
        if (kb > 0) { ATT_DMA(kb - 1, cur ^ 1); asm volatile("s_waitcnt vmcnt(8)" ::: "memory"); }
        else asm volatile("s_waitcnt vmcnt(0)" ::: "memory");
        const LAS unsigned char* Kb = lw + cur * 8192; const LAS unsigned char* Vb = Kb + 4096;
        bf16x8 kf[4];
#pragma unroll
        for (int ks = 0; ks < 4; ++ks) kf[ks] = *(const LAS bf16x8*)(Kb + kfb + (((2 * ks + hi) ^ (r32 & 7)) * 16));
        const bool doA = liveA, doB = liveB && (kb <= jB);
#define ATT_STEP(DA, DB, GA, GB) do { u32x4 pA0, pA1, pB0, pB1; \
            if (DA) attn_block_scores<GA>(kf, qfA, tri, r32, hi, carryA, pA0, pA1); \
            if (DB) attn_block_scores<GB>(kf, qfB, tri, r32, hi, carryB, pB0, pB1); \
            _Pragma("unroll") for (int ks = 0; ks < 2; ++ks) { _Pragma("unroll") for (int db = 0; db < 2; ++db) { const int d_ = 32 * db + r32, sw_ = (d_ >> 2) & 3; const LAS unsigned char* vp = Vb + d_ * 64 + 8 * hi; \
                const u32x2 lo = *(const LAS u32x2*)(vp + (((2 * ks) ^ sw_) * 16)), hh = *(const LAS u32x2*)(vp + (((2 * ks + 1) ^ sw_) * 16)); const u32x4 vv = {lo.x, lo.y, hh.x, hh.y}; const bf16x8 vf = __builtin_bit_cast(bf16x8, vv); \
                if (DA) { const bf16x8 pb = __builtin_bit_cast(bf16x8, ks ? pA1 : pA0); if (db == 0) oA0 = __builtin_amdgcn_mfma_f32_32x32x16_bf16(vf, pb, oA0, 0, 0, 0); else oA1 = __builtin_amdgcn_mfma_f32_32x32x16_bf16(vf, pb, oA1, 0, 0, 0); } \
                if (DB) { const bf16x8 pb = __builtin_bit_cast(bf16x8, ks ? pB1 : pB0); if (db == 0) oB0 = __builtin_amdgcn_mfma_f32_32x32x16_bf16(vf, pb, oB0, 0, 0, 0); else oB1 = __builtin_amdgcn_mfma_f32_32x32x16_bf16(vf, pb, oB1, 0, 0, 0); } } } } while (0)
        if (kb == jA) ATT_STEP(true, false, true, false);
        else if (kb == jB) { if (doA) ATT_STEP(true, true, false, true); else ATT_STEP(false, true, false, true); }
        else if (doA && doB) ATT_STEP(true, true, false, false);
        else if (doA) ATT_STEP(true, false, false, false);
        else if (doB) ATT_STEP(false, true, false, false);
#undef ATT_STEP
        asm volatile("s_waitcnt lgkmcnt(0)" ::: "memory");
        cur ^= 1;
        if (doA && __builtin_amdgcn_ballot_w64(carryA > -150.0f) == 0ull) liveA = false;
        if (doB && __builtin_amdgcn_ballot_w64(carryB > -150.0f) == 0ull) liveB = false;
        if (!liveA && !liveB) break;
    }
    asm volatile("s_waitcnt vmcnt(0)" ::: "memory");
#pragma unroll
    for (int sub = 0; sub < 2; ++sub) { const f32x16& o0 = sub ? oB0 : oA0; const f32x16& o1 = sub ? oB1 : oA1;
        bf16* orow8 = MIX + ((size_t)b * SEQ + 32 * (sub ? jB : jA) + r32) * DM + POOLW + h * 64 + 8 * hi;
#pragma unroll
        for (int gp = 0; gp < 2; ++gp) {
#pragma unroll
            for (int hf = 0; hf < 2; ++hf) { const f32x16& o = hf ? o1 : o0; const int g0 = 2 * gp, g1 = 2 * gp + 1;
                const unsigned a0 = cvtpk(o[4 * g0], o[4 * g0 + 1]), a1 = cvtpk(o[4 * g0 + 2], o[4 * g0 + 3]), b0 = cvtpk(o[4 * g1], o[4 * g1 + 1]), b1 = cvtpk(o[4 * g1 + 2], o[4 * g1 + 3]);
                const auto s0 = __builtin_amdgcn_permlane32_swap(a0, b0, false, false); const auto s1 = __builtin_amdgcn_permlane32_swap(a1, b1, false, false);
                u32x4 w; w.x = s0[0]; w.y = s1[0]; w.z = s0[1]; w.w = s1[1];
                *(u32x4*)(orow8 + 32 * hf + 16 * gp) = w; } } }
#undef ATT_DMA
}

constexpr int NWAVES = 8;
__global__ void __launch_bounds__(NWAVES * 64, 2) fwd(Args args) {
    extern __shared__ __attribute__((aligned(16))) unsigned char lds_raw[];
    LAS unsigned char* lds = (LAS unsigned char*)lds_raw;
    volatile LAS unsigned* MISC = (volatile LAS unsigned*)(lds + MISC_OFF);
    const int tid = threadIdx.x, lane = tid & 63, wave = __builtin_amdgcn_readfirstlane(tid >> 6);
    const int G = gridDim.x, bx = blockIdx.x;
    unsigned char* ws = args.ws;
    unsigned* ctl = (unsigned*)(ws + WS_CTL);
    const float* x = args.in[0]; const float* pin = args.in[1]; const float* ln_mix_g = args.in[2]; const float* w_in = args.in[3]; const float* pool_w = args.in[4]; const float* pool_scale = args.in[5];
    const float* q_norm_g = args.in[6]; const float* k_norm_g = args.in[7]; const float* w_out = args.in[8]; const float* ln_ffn_g = args.in[9]; const float* router_w = args.in[10]; const float* router_b = args.in[11];
    const float* w_gate_up = args.in[12]; const float* b_gate_up = args.in[13]; const float* w_down = args.in[14]; const float* b_down = args.in[15]; const float* ln_ple_g = args.in[16];
    const float* ple_gate_w = args.in[17]; const float* ple_proj = args.in[18]; const float* ple_norm_g = args.in[19];
    bf16* WinT = (bf16*)(ws + WS_WINT); bf16* WvT = (bf16*)(ws + WS_WVT); bf16* PoolT = (bf16*)(ws + WS_POOLT); bf16* WRhi = (bf16*)(ws + WS_WRHI); bf16* WRlo = (bf16*)(ws + WS_WRLO);
    bf16* WoutT = (bf16*)(ws + WS_WOUTT); unsigned char* Wgate8 = ws + WS_WGATET; bf16* WprojT = (bf16*)(ws + WS_WPROJT); bf16* Pbf = (bf16*)(ws + WS_PBF);
    int* LFLAT = (int*)(ws + WS_LFLAT); float* LGATE = (float*)(ws + WS_LGATE); float* LRSTD = (float*)(ws + WS_LRSTD); float* SSE = (float*)(ws + WS_SSE); float* RSTDE = (float*)(ws + WS_RSTDE);
    bf16* HN = (bf16*)(ws + WS_HN); bf16* Ub = (bf16*)(ws + WS_U); bf16* Qb = (bf16*)(ws + WS_Q); bf16* Kb = (bf16*)(ws + WS_K); bf16* VT = (bf16*)(ws + WS_VT); bf16* DD = (bf16*)(ws + WS_DD);
    bf16* MIX = (bf16*)(ws + WS_MIX); bf16* H1 = (bf16*)(ws + WS_H1); unsigned char* XG2 = ws + WS_XG2; bf16* ERAW = (bf16*)(ws + WS_ERAW); unsigned char* Wgu8 = ws + WS_WGUT; unsigned char* Wd8 = ws + WS_WDT;
    unsigned char* ACT = ws + WS_ACT; unsigned char* Y4 = ws + WS_Y4; unsigned char* XG3 = ws + WS_HN; bf16* H2b = (bf16*)(ws + WS_XG2);

    for (int u = tid; u < (LDS_BYTES - LDSCTL_OFF) / 4; u += NWAVES * 64) ((LAS unsigned*)(lds + LDSCTL_OFF))[u] = 0u;
    __syncthreads();
    XcdBarrier bar; bar.bar = ctl + CW_BAR; bar.x = 0; bar.st = nullptr;
    if (MK_ONE_LAUNCH) bar = xcd_barrier_post(ctl + CW_BAR, MISC + 8);
    const int lo = args.ph_lo, hi = args.ph_hi;
#ifndef DUP_PHASE
#define DUP_PHASE -1
#endif
#define REP(k) for (int rep_ = 0; rep_ < ((DUP_PHASE == (k)) ? 2 : 1); ++rep_)
#ifndef PHASE_MASK
#define PHASE_MASK 0x3ff
#endif
#define IN(k) (((PHASE_MASK >> (k)) & 1) && lo <= (k) && (k) < hi)
#define SEAM(k) do { if (IN(k) && IN((k) + 1)) xcd_barrier(bar); } while (0)
    const int gw = bx * NWAVES + wave, NGW = G * NWAVES;
    const int gt = bx * (NWAVES * 64) + tid, NGT = G * NWAVES * 64;

    if (IN(0)) REP(0) {
        LAS float* scr = (LAS float*)(lds + wave * 16384);
        constexpr int I_IN = 32 * 128, I_POOL = 4 * 4 * 8, I_OUT = 32 * 64, I_GATE = 32 * 64, I_PROJ = 4 * 64;
        constexpr int NITEMS = I_IN + I_POOL + I_OUT + I_GATE + I_PROJ;
        for (int it = gw; it < NITEMS; it += NGW) {
            int r = it;
            if (r < I_IN) { const int kb = r / 128, nb = r % 128, n0 = nb * 32; bf16* dst;
                if (n0 < 1024) dst = WinT + (size_t)n0 * DM;
                else if (n0 < 3072) { const int part = (n0 - 1024) / 1024, nn = (n0 - 1024) % 1024, head = nn >> 6, d0 = nn & 63, tile = head >> 2, hl = head & 3;
                    dst = WinT + ((size_t)1024 + part * 1024 + tile * 256 + 128 * (d0 >> 5) + 32 * hl) * DM; }
                else dst = WvT + (size_t)(n0 - 3072) * DM;
                tr_item(w_in, 4096, dst, DM, kb * 64, n0, scr, lane); continue; } r -= I_IN;
            if (r < I_POOL) { const int g = r / 32, q = r % 32, kb = q / 8, nb = q % 8;
                tr_item(pool_w + (size_t)g * 65536, 256, PoolT + ((size_t)g * 256 + nb * 32) * 256, 256, kb * 64, nb * 32, scr, lane); continue; } r -= I_POOL;
            if (r < I_OUT) { const int kb = r / 64, nb = r % 64; tr_item(w_out, DM, WoutT + (size_t)nb * 32 * DM, DM, kb * 64, nb * 32, scr, lane); continue; } r -= I_OUT;
            if (r < I_GATE) { const int kb = r / 64, nb = r % 64, n0 = nb * 32; auto rm = [n0](int nn) { return n0 + nn; };
                tr_item_fp8(ple_gate_w, DM, Wgate8, DM, kb * 64, n0, SC_W8, rm, scr, lane); continue; } r -= I_GATE;
            { const int kb = r / 64, nb = r % 64; tr_item(ple_proj, DM, WprojT + (size_t)nb * 32 * PLE, PLE, kb * 64, nb * 32, scr, lane); }
        }
        for (int i = gt; i < NE * DM; i += NGT) { const int e = i / DM, k = i % DM; const float w = router_w[k * NE + e] * ln_ffn_g[k];
            const unsigned h16 = f2bf(w); const float hf = __uint_as_float(h16 << 16); WRhi[i] = (bf16)h16; WRlo[i] = (bf16)f2bf(w - hf); }
        for (int i = gt; i < T * PLE / 8; i += NGT) { const f32x4 a = *(const f32x4*)(pin + (size_t)i * 8), b = *(const f32x4*)(pin + (size_t)i * 8 + 4);
            u32x4 w; w.x = pk2(a[0], a[1]); w.y = pk2(a[2], a[3]); w.z = pk2(b[0], b[1]); w.w = pk2(b[2], b[3]); *(u32x4*)(Pbf + (size_t)i * 8) = w; }
        for (int m = gw; m < T; m += NGW) { const f32x4* xr = (const f32x4*)(x + (size_t)m * DM) + lane; f32x4 v[8]; float s = 0.f;
#pragma unroll
            for (int j = 0; j < 8; ++j) { v[j] = xr[64 * j]; s += (v[j][0] * v[j][0] + v[j][1] * v[j][1]) + (v[j][2] * v[j][2] + v[j][3] * v[j][3]); }
            const float rstd = 1.0f / sqrtf(wave_sum(s) * (1.0f / DM) + EPS);
            u32x2* o8 = (u32x2*)(HN + (size_t)m * DM) + lane;
#pragma unroll
            for (int j = 0; j < 8; ++j) { const f32x4 g = *((const f32x4*)ln_mix_g + lane + 64 * j); u32x2 w; w.x = pk2(v[j][0] * rstd * g[0], v[j][1] * rstd * g[1]); w.y = pk2(v[j][2] * rstd * g[2], v[j][3] * rstd * g[3]); o8[64 * j] = w; } }
        __syncthreads();
    }
    SEAM(0);

#define CONV_RANGE(i_lo, i_hi) do { for (int ci_ = (i_lo); ci_ < (i_hi); ++ci_) { const int tk = gw + NGW * ci_; if (tk < 32768 + 16384) { \
        if (tk < 32768) { const int e = tk >> 10, rem = tk & 1023, kb = rem >> 6, nb = rem & 63; conv_task2<true>(w_gate_up + (size_t)e * DM * 4096, 4096, Wgu8 + (size_t)e * 4096 * DM, kb * 128, nb * 64, lane); } \
        else { const int t2 = tk - 32768, e = t2 >> 9, rem = t2 & 511, kb = rem >> 5, nb = rem & 31; conv_task2<false>(w_down + (size_t)e * FF * DM, DM, Wd8 + (size_t)e * DM * FF, kb * 128, nb * 64, lane); } } } } while (0)
    if (IN(1)) {
        const int conv_n = (32768 + 16384 + NGW - 1) / NGW, conv_n1 = (conv_n * (bx & 7)) >> 3;
        CONV_RANGE(0, conv_n1);
        REP(10) { pg8::DenseOrder S; S.init(HN, WinT, DM, DM, T, 3072, G, bx); pg8::EpiInProj E{Ub, Qb, Kb, q_norm_g, k_norm_g}; pg8::gemm_phase(lds, S, E); }
        __syncthreads();
        REP(11) { pg8::DenseOrder S; S.init(WvT, HN, DM, DM, 1024, T, G, bx); pg8::EpiPlain E{VT, T, nullptr, 0}; pg8::gemm_phase(lds, S, E); }
        __syncthreads();
        CONV_RANGE(conv_n1, conv_n);
    }
    SEAM(1);

    if (IN(2)) REP(2) {
        { bf16x8 tri[2];
#pragma unroll
          for (int ks = 0; ks < 2; ++ks)
#pragma unroll
              for (int i = 0; i < 8; ++i) tri[ks][i] = (crow(8 * ks + i, lane >> 5) > (lane & 31)) ? (short)0x3F80 : (short)0;
          LAS unsigned char* lw = lds + wave * 16384;
          REP(20) for (int u = gw; u < BATCH * NH * (SEQ / 64); u += NGW) { const int bh = u >> 5, jp = 31 - (u & 31); attn_wave_pair(lw, Qb, Kb, VT, MIX, bh / NH, bh % NH, jp, tri); } }
#define POOL_GROUP(g_) do { constexpr int W_ = 2 << (g_); \
        for (int it = gt; it < T * 32; it += NGT) { const int tok = it >> 5, c8 = (g_) * 32 + (it & 31), s = tok & (SEQ - 1); const int n = (s + 1 < W_) ? s + 1 : W_; \
            const bf16* up = Ub + (size_t)tok * POOLW + c8 * 8; u32x4 q[W_]; \
            _Pragma("unroll") for (int j = 0; j < W_; ++j) q[j] = *(const u32x4*)(up - (size_t)((j < n) ? j : 0) * POOLW); \
            float sum[8] = {0.f, 0.f, 0.f, 0.f, 0.f, 0.f, 0.f, 0.f}; \
            _Pragma("unroll") for (int j = 0; j < W_; ++j) { const float m_ = (j < n) ? 1.0f : 0.0f; \
                sum[0] += m_ * bf_lo(q[j].x); sum[1] += m_ * bf_hi(q[j].x); sum[2] += m_ * bf_lo(q[j].y); sum[3] += m_ * bf_hi(q[j].y); sum[4] += m_ * bf_lo(q[j].z); sum[5] += m_ * bf_hi(q[j].z); sum[6] += m_ * bf_lo(q[j].w); sum[7] += m_ * bf_hi(q[j].w); } \
            const float inv = 1.0f / (float)n; u32x4 o; \
            o.x = pk2(sum[0] * inv - bf_lo(q[0].x), sum[1] * inv - bf_hi(q[0].x)); o.y = pk2(sum[2] * inv - bf_lo(q[0].y), sum[3] * inv - bf_hi(q[0].y)); \
            o.z = pk2(sum[4] * inv - bf_lo(q[0].z), sum[5] * inv - bf_hi(q[0].z)); o.w = pk2(sum[6] * inv - bf_lo(q[0].w), sum[7] * inv - bf_hi(q[0].w)); \
            *(u32x4*)(DD + (size_t)tok * POOLW + c8 * 8) = o; } } while (0)
        POOL_GROUP(0); POOL_GROUP(1); POOL_GROUP(2); POOL_GROUP(3);
#undef POOL_GROUP
        __syncthreads();
    }
    SEAM(2);

    if (IN(3)) REP(3) {
        { pg8::PoolOrder S{(const char*)DD, (const char*)PoolT, POOLW, 256, G, bx}; pg8::EpiPlain E{MIX, DM, pool_scale, 0}; pg8::gemm_phase(lds, S, E); }
        __syncthreads();
        { pg8::DenseOrder S; S.init(Pbf, WprojT, PLE, PLE, T, DM, G, bx); pg8::EpiE E{ERAW, SSE}; pg8::gemm_phase(lds, S, E); }
        __syncthreads();
    }
    SEAM(3);

    if (IN(4)) REP(4) {
        pg8::DenseOrder S; S.init(MIX, WoutT, DM, DM, T, DM, G, bx); pg8::EpiWout E{x, H1, XG2, ln_ffn_g}; pg8::gemm_phase(lds, S, E);
        __syncthreads();
    }
    SEAM(4);

    if (IN(5)) {
        LAS float* lg = (LAS float*)lds;
        LAS float* lrs = (LAS float*)(lds + 20480);
        LAS int* lcnt = (LAS int*)(lds + 21504);
        LAS int* lbase = (LAS int*)(lds + 21760);
        LAS int* ent_e = (LAS int*)(lds + 22528);
        LAS int* ent_rank = (LAS int*)(lds + 24576);
        LAS float* ent_gate = (LAS float*)(lds + 26624);
        for (int chunk = bx; chunk < T / 128; chunk += G) {
            const int tok0 = chunk * 128;
            if (tid < 32) lcnt[tid] = 0;
            __syncthreads();
            const int tl = lane & 15, kq = lane >> 4, tokn = tok0 + wave * 16 + tl;
            f32x4 a0 = {0.f, 0.f, 0.f, 0.f}, a1 = {0.f, 0.f, 0.f, 0.f}; float ss = 0.f;
            const bf16* xr = H1 + (size_t)tokn * DM + 8 * kq;
            LAS unsigned char* wbuf = lds + 32768; constexpr int WROW = 528, WMAT = 32 * WROW, WBUF = 2 * WMAT;
            u32x4 wreg[4];
#define RT_LOAD(c) do { _Pragma("unroll") for (int q_ = 0; q_ < 4; ++q_) { const int p_ = tid + 512 * q_, mat_ = p_ >> 10, e_ = (p_ >> 5) & 31, c16_ = p_ & 31; \
                wreg[q_] = *(const u32x4*)((mat_ ? WRlo : WRhi) + (size_t)e_ * DM + (c) * 256 + c16_ * 8); } } while (0)
#define RT_STORE(b) do { _Pragma("unroll") for (int q_ = 0; q_ < 4; ++q_) { const int p_ = tid + 512 * q_, mat_ = p_ >> 10, e_ = (p_ >> 5) & 31, c16_ = p_ & 31; \
                *(LAS u32x4*)(wbuf + (b) * WBUF + mat_ * WMAT + e_ * WROW + c16_ * 16) = wreg[q_]; } } while (0)
            RT_LOAD(0); RT_STORE(0); __syncthreads();
            for (int c = 0; c < 8; ++c) {
                if (c < 7) RT_LOAD(c + 1);
                const LAS unsigned char* wb = wbuf + (c & 1) * WBUF + tl * WROW + kq * 16;
#pragma unroll
                for (int s8 = 0; s8 < 8; ++s8) { const int ks = c * 8 + s8;
                    const u32x4 xh = *(const u32x4*)(xr + 32 * ks);
                    { const float f0 = bf_lo(xh.x), f1 = bf_hi(xh.x), f2 = bf_lo(xh.y), f3 = bf_hi(xh.y), f4 = bf_lo(xh.z), f5 = bf_hi(xh.z), f6 = bf_lo(xh.w), f7 = bf_hi(xh.w);
                      ss += (f0 * f0 + f1 * f1) + (f2 * f2 + f3 * f3) + (f4 * f4 + f5 * f5) + (f6 * f6 + f7 * f7); }
                    const bf16x8 bxh = __builtin_bit_cast(bf16x8, xh);
                    const bf16x8 ah0 = *(const LAS bf16x8*)(wb + s8 * 64), ah1 = *(const LAS bf16x8*)(wb + 16 * WROW + s8 * 64), al0 = *(const LAS bf16x8*)(wb + WMAT + s8 * 64), al1 = *(const LAS bf16x8*)(wb + WMAT + 16 * WROW + s8 * 64);
                    a0 = __builtin_amdgcn_mfma_f32_16x16x32_bf16(ah0, bxh, a0, 0, 0, 0); a0 = __builtin_amdgcn_mfma_f32_16x16x32_bf16(al0, bxh, a0, 0, 0, 0);
                    a1 = __builtin_amdgcn_mfma_f32_16x16x32_bf16(ah1, bxh, a1, 0, 0, 0); a1 = __builtin_amdgcn_mfma_f32_16x16x32_bf16(al1, bxh, a1, 0, 0, 0); }
                if (c < 7) RT_STORE((c + 1) & 1);
                __syncthreads();
            }
#undef RT_LOAD
#undef RT_STORE
            ss += __shfl_xor(ss, 16); ss += __shfl_xor(ss, 32);
            const float rstd = 1.0f / sqrtf(ss * (1.0f / DM) + EPS);
            LAS float* lgw = lg + (wave * 16 + tl) * 33;
#pragma unroll
            for (int j = 0; j < 4; ++j) { lgw[4 * kq + j] = a0[j] * rstd + router_b[4 * kq + j]; lgw[16 + 4 * kq + j] = a1[j] * rstd + router_b[16 + 4 * kq + j]; }
            if (kq == 0) lrs[wave * 16 + tl] = rstd;
            __syncthreads();
            if (tid < 128) {
                const LAS float* l = lg + tid * 33; float v[4]; int id[4]; unsigned used = 0u;
#pragma unroll
                for (int k = 0; k < 4; ++k) { float best = -3.0e38f; int bi = 0;
                    for (int e = 0; e < NE; ++e) { const float f = l[e]; const bool ok = !((used >> e) & 1u) && (f > best); best = ok ? f : best; bi = ok ? e : bi; }
                    v[k] = best; id[k] = bi; used |= 1u << bi; }
                const float e1 = __expf(v[1] - v[0]), e2 = __expf(v[2] - v[0]), e3 = __expf(v[3] - v[0]); const float inv = 1.0f / (1.0f + e1 + e2 + e3);
                const float gk[4] = {inv, e1 * inv, e2 * inv, e3 * inv};
#pragma unroll
                for (int k = 0; k < 4; ++k) { const int rk = atomicAdd((int*)(lcnt + id[k]), 1); ent_e[tid * 4 + k] = id[k]; ent_rank[tid * 4 + k] = rk; ent_gate[tid * 4 + k] = gk[k]; }
            }
            __syncthreads();
            if (tid < 32) lbase[tid] = (int)__hip_atomic_fetch_add(ctl + CW_CNT + tid, (unsigned)lcnt[tid], __ATOMIC_RELAXED, __HIP_MEMORY_SCOPE_AGENT);
            __syncthreads();
            { const int e = ent_e[tid], pos = lbase[e] + ent_rank[tid]; const size_t o = (size_t)e * LCAP + pos;
              LFLAT[o] = tok0 * 4 + tid; LGATE[o] = ent_gate[tid]; LRSTD[o] = lrs[tid >> 2]; }
            __syncthreads();
        }
    }
    SEAM(5);

    if (IN(6) || IN(7)) {
        LAS int* tab = (LAS int*)(lds + TAB_OFF);
        if (tid < 32) {
            const int c = (int)__hip_atomic_load(ctl + CW_CNT + tid, __ATOMIC_RELAXED, __HIP_MEMORY_SCOPE_AGENT); const int nb = (c + 255) >> 8; int incl = nb;
#pragma unroll
            for (int o = 1; o < 32; o <<= 1) { const int v = __shfl_up(incl, o, 32); incl += (tid >= o) ? v : 0; }
            tab[tid] = incl - nb; tab[40 + tid] = c; if (tid == 31) tab[32] = incl; }
        __syncthreads();
    }
    if (IN(6)) REP(6) {
        pg8::MoeOrder<16, true> S{(const char*)XG2, (const char*)Wgu8, DM / 2, DM / 2, G, bx, (const LAS int*)(lds + TAB_OFF), LFLAT, LRSTD, b_gate_up};
        pg8::EpiGU E{ACT}; pg8::gemm_phase(lds, S, E);
        __syncthreads();
    }
    SEAM(6);
    if (IN(7)) REP(7) {
        pg8::MoeOrder<8, false> S{(const char*)ACT, (const char*)Wd8, FF / 2, FF / 2, G, bx, (const LAS int*)(lds + TAB_OFF), LFLAT, LGATE, b_down};
        pg8::EpiDown E{Y4}; pg8::gemm_phase(lds, S, E);
        __syncthreads();
    }
    SEAM(7);

    if (IN(8)) REP(8) {
        for (int m = gw; m < T; m += NGW) { const u32x2* hr = (const u32x2*)(H1 + (size_t)m * DM) + lane; f32x4 v[8]; float s = 0.f;
#pragma unroll
            for (int j = 0; j < 8; ++j) { const u32x2 hq = hr[64 * j]; v[j] = (f32x4){bf_lo(hq.x), bf_hi(hq.x), bf_lo(hq.y), bf_hi(hq.y)}; }
#pragma unroll
            for (int k = 0; k < 4; ++k) { const unsigned* yr = (const unsigned*)(Y4 + ((size_t)m * 4 + k) * DM) + lane;
#pragma unroll
                for (int j = 0; j < 8; ++j) { const unsigned y = yr[64 * j]; const f32x2 lo = __builtin_amdgcn_cvt_pk_f32_fp8(y, false), hh = __builtin_amdgcn_cvt_pk_f32_fp8(y, true);
                    v[j][0] += lo[0] * (1.0f / SC_Y8); v[j][1] += lo[1] * (1.0f / SC_Y8); v[j][2] += hh[0] * (1.0f / SC_Y8); v[j][3] += hh[1] * (1.0f / SC_Y8); } }
            u32x2* h8 = (u32x2*)(H2b + (size_t)m * DM) + lane;
#pragma unroll
            for (int j = 0; j < 8; ++j) { u32x2 w; w.x = pk2(v[j][0], v[j][1]); w.y = pk2(v[j][2], v[j][3]); h8[64 * j] = w; s += (v[j][0] * v[j][0] + v[j][1] * v[j][1]) + (v[j][2] * v[j][2] + v[j][3] * v[j][3]); }
            const float rstd = SC_G8 / sqrtf(wave_sum(s) * (1.0f / DM) + EPS);
            unsigned* o4 = (unsigned*)(XG3 + (size_t)m * DM) + lane;
#pragma unroll
            for (int j = 0; j < 8; ++j) { const f32x4 g = *((const f32x4*)ln_ple_g + lane + 64 * j); o4[64 * j] = pk4_fp8(v[j][0] * rstd * g[0], v[j][1] * rstd * g[1], v[j][2] * rstd * g[2], v[j][3] * rstd * g[3]); }
            const float se = wave_sum(lane < 32 ? SSE[(size_t)m * 32 + lane] : 0.f);
            if (lane == 0) RSTDE[m] = 1.0f / sqrtf(se * (1.0f / DM) + EPS); }
        __syncthreads();
    }
    SEAM(8);

    if (IN(9)) REP(9) {
        pg8::DenseOrderT<true> S; S.init(XG3, Wgate8, DM / 2, DM / 2, T, DM, G, bx); pg8::EpiGate E{H2b, ERAW, RSTDE, ple_norm_g, args.out}; pg8::gemm_phase(lds, S, E);
    }
#undef IN
#undef SEAM
}

extern "C" void kernel_launch(void* const* d_in, const int* in_sizes, int n_in, void* d_out, int out_size, void* d_ws, size_t ws_size, hipStream_t stream) {
    static int grid = 0;
    if (grid == 0) {
        if (n_in != 20 || out_size != T * DM || ws_size < WS_END) { fprintf(stderr, "kernel_launch: unexpected shapes (n_in %d, out %d, ws %zu < %zu)\n", n_in, out_size, ws_size, (size_t)WS_END); grid = -1; return; }
        int dev = 0, cus = 0, per_cu = 0;
        if (hipGetDevice(&dev) != hipSuccess || hipDeviceGetAttribute(&cus, hipDeviceAttributeMultiprocessorCount, dev) != hipSuccess) { grid = -1; return; }
        if (hipFuncSetAttribute((const void*)fwd, hipFuncAttributeMaxDynamicSharedMemorySize, LDS_BYTES) != hipSuccess) { fprintf(stderr, "kernel_launch: hipFuncSetAttribute failed\n"); grid = -1; return; }
        if (hipOccupancyMaxActiveBlocksPerMultiprocessor(&per_cu, (const void*)fwd, NWAVES * 64, LDS_BYTES) != hipSuccess || per_cu < 1) fprintf(stderr, "kernel_launch: occupancy query says %d\n", per_cu);
        (void)hipGetLastError();
        grid = cus;
    }
    if (grid < 0) return;
    (void)hipMemsetAsync((char*)d_ws + WS_CTL, 0, CTL_ZERO_BYTES, stream);
    Args a{};
    for (int i = 0; i < 20; ++i) a.in[i] = (const float*)d_in[i];
    a.out = (float*)d_out; a.ws = (unsigned char*)d_ws;
#if MK_ONE_LAUNCH
    a.ph_lo = 0; a.ph_hi = NPHASE;
    hipLaunchKernelGGL(fwd, dim3(grid), dim3(NWAVES * 64), LDS_BYTES, stream, a);
#else
    for (int p = 0; p < NPHASE; ++p) { a.ph_lo = p; a.ph_hi = p + 1; hipLaunchKernelGGL(fwd, dim3(grid), dim3(NWAVES * 64), LDS_BYTES, stream, a); }
#endif
}
```

```cpp
#include <hip/hip_runtime.h>
#include <cstdio>
#include <cstdint>

#define GAS __attribute__((address_space(1)))
#define LAS __attribute__((address_space(3)))
typedef unsigned short bf16;
typedef short bf16x8 __attribute__((ext_vector_type(8)));
typedef float f32x4 __attribute__((ext_vector_type(4)));
typedef float f32x2 __attribute__((ext_vector_type(2)));
typedef float f32x16 __attribute__((ext_vector_type(16)));
typedef unsigned u32x4 __attribute__((ext_vector_type(4)));
typedef unsigned u32x2 __attribute__((ext_vector_type(2)));
typedef int i32x4 __attribute__((ext_vector_type(4)));
typedef int i32x8 __attribute__((ext_vector_type(8)));

#ifndef KROT_MOE
#define KROT_MOE 1
#endif
#ifndef KROT_DENSE
#define KROT_DENSE 0
#endif
#ifndef MK_ONE_LAUNCH
#define MK_ONE_LAUNCH 1
#endif

constexpr int BATCH = 16, SEQ = 2048, T = BATCH * SEQ, DM = 2048, PLE = 256, POOLW = 1024, NH = 16, HD = 64, NE = 32, FF = 2048;
constexpr int LCAP = 32768;
constexpr float EPS = 1e-6f;
constexpr float LOG2E = 1.4426950408889634f;
constexpr int NPHASE = 10;

constexpr size_t MiB = 1u << 20;
constexpr size_t WS_CTL = 0, CTL_ZERO_BYTES = 1 * MiB;
constexpr size_t WS_WINT = 2 * MiB;
constexpr size_t WS_WVT = 14 * MiB;
constexpr size_t WS_POOLT = 18 * MiB;
constexpr size_t WS_WRHI = 19 * MiB;
constexpr size_t WS_WRLO = 19 * MiB + 512 * 1024;
constexpr size_t WS_WOUTT = 20 * MiB;
constexpr size_t WS_WGATET = 28 * MiB;
constexpr size_t WS_WPROJT = 36 * MiB;
constexpr size_t WS_PBF = 38 * MiB;
constexpr size_t WS_LFLAT = 54 * MiB, WS_LGATE = 58 * MiB, WS_LRSTD = 62 * MiB;
constexpr size_t WS_SSE = 66 * MiB;
constexpr size_t WS_RSTDE = 70 * MiB;
constexpr size_t WS_HN = 72 * MiB;
constexpr size_t WS_U = 200 * MiB;
constexpr size_t WS_Q = 264 * MiB;
constexpr size_t WS_K = 328 * MiB;
constexpr size_t WS_VT = 392 * MiB;
constexpr size_t WS_DD = 456 * MiB;
constexpr size_t WS_MIX = 520 * MiB;
constexpr size_t WS_H1 = 648 * MiB;
constexpr size_t WS_XG2 = 904 * MiB;
constexpr size_t WS_ERAW = 1032 * MiB;
constexpr size_t WS_WGUT = 1160 * MiB;
constexpr size_t WS_WDT = 1672 * MiB;
constexpr size_t WS_ACT = 1928 * MiB;
constexpr size_t WS_Y4 = 2472 * MiB;
constexpr size_t WS_END = 2984 * MiB;
constexpr int CW_CNT = 64;
constexpr int CW_BAR = 4096;

constexpr int RING_BYTES = 131072;
constexpr int LDSCTL_OFF = RING_BYTES, MISC_OFF = LDSCTL_OFF + 320, TAB_OFF = LDSCTL_OFF + 1024;
constexpr int META_OFF = LDSCTL_OFF + 2048, META_SLOT = 3072;
constexpr int LDS_BYTES = 147456;

__device__ __forceinline__ unsigned cvt_pk_bf16(float lo, float hi) { unsigned r; asm volatile("v_cvt_pk_bf16_f32 %0, %1, %2" : "=v"(r) : "v"(lo), "v"(hi)); return r; }
__device__ __forceinline__ unsigned cvtpk(float lo, float hi) { typedef __bf16 bf2 __attribute__((ext_vector_type(2))); f32x2 v = {lo, hi}; bf2 b = __builtin_convertvector(v, bf2); return __builtin_bit_cast(unsigned, b); }
__device__ __forceinline__ float bf_lo(unsigned w) { return __uint_as_float(w << 16); }
__device__ __forceinline__ float bf_hi(unsigned w) { return __uint_as_float(w & 0xffff0000u); }
__device__ __forceinline__ float wave_sum(float v) {
#pragma unroll
    for (int o = 1; o < 64; o <<= 1) v += __shfl_xor(v, o);
    return v;
}
__device__ __forceinline__ u32x4 pair16(const u32x2& wa, const u32x2& wb) {
    const auto sx = __builtin_amdgcn_permlane16_swap(wa.x, wb.x, false, false); const auto sy = __builtin_amdgcn_permlane16_swap(wa.y, wb.y, false, false);
    u32x4 o; o.x = sx[0]; o.y = sy[0]; o.z = sx[1]; o.w = sy[1]; return o; }
__device__ __forceinline__ unsigned pk4_fp8(float a, float b, float c, float d) {
    a = __builtin_amdgcn_fmed3f(a, -448.f, 448.f); b = __builtin_amdgcn_fmed3f(b, -448.f, 448.f); c = __builtin_amdgcn_fmed3f(c, -448.f, 448.f); d = __builtin_amdgcn_fmed3f(d, -448.f, 448.f);
    int r = __builtin_amdgcn_cvt_pk_fp8_f32(a, b, 0, false); r = __builtin_amdgcn_cvt_pk_fp8_f32(c, d, r, true); return (unsigned)r; }
__device__ __forceinline__ unsigned pk4_fp8_nc(float a, float b, float c, float d) { int r = __builtin_amdgcn_cvt_pk_fp8_f32(a, b, 0, false); r = __builtin_amdgcn_cvt_pk_fp8_f32(c, d, r, true); return (unsigned)r; }
constexpr float SC_Y8 = 32.f;
constexpr float SC_G8 = 8.f;
constexpr float SC_X8 = 16.f, SC_W8 = 64.f, SC_A8 = 4.f;
__device__ __forceinline__ float fast_sigmoid(float x) { return __builtin_amdgcn_rcpf(1.0f + __builtin_amdgcn_exp2f(-x * LOG2E)); }

namespace pg8 {
constexpr int BM = 256, BK = 64, HALF = 128, HTB = HALF * BK * 2, STAGE_BYTES = 8 * HTB, NXCD = 8, WGM = 8;
__host__ __device__ __forceinline__ int lds_byte(int r, int c) { const int st = (r >> 4) * 2 + (c >> 5), rr = r & 15, cc = c & 31, ob = rr * 64 + cc * 2; return st * 1024 + (ob ^ (((ob >> 9) & 1) << 5)); }
__host__ __device__ __forceinline__ void stage_rc(int b, int& R, int& C) { const int st = b / 1024, sb = b % 1024, swz = sb ^ (((sb >> 9) & 1) << 5); R = (st >> 1) * 16 + swz / 64; C = (st & 1) * 32 + (swz % 64) / 2; }
__host__ __device__ __forceinline__ int perm32(int rho) { const int n = rho >> 4, i = rho & 15; return 8 * (i >> 2) + 4 * n + (i & 3); }

struct Unit { int pm, pn, e, r0, nrows, rb; };

template <class Epi, class Sched>
__device__ __forceinline__ void gemm_phase(LAS unsigned char* lds, const Sched& S, const Epi& E) {
    constexpr bool GATHER = Sched::GATHER; constexpr bool FP8 = Sched::FP8; constexpr bool META = Sched::META; constexpr bool KROT = Sched::KROT;
    const int tid = threadIdx.x, wid = __builtin_amdgcn_readfirstlane(tid >> 6), lane = tid & 63, wr = wid >> 2, wc = wid & 3, fr = lane & 15, fq = lane >> 4;
    const int K = S.K, nt = K / BK, lda = S.lda;
    unsigned voffA[2], voffB[2]; int RA[2], CA[2];
#pragma unroll
    for (int i = 0; i < 2; ++i) { int R, C; stage_rc(tid * 16 + i * 8192, R, C); const int Rb = (R & ~31) + perm32(R & 31);
        RA[i] = R; CA[i] = C; voffA[i] = (unsigned)(R * lda + C) * 2u; voffB[i] = (unsigned)(Rb * K + C) * 2u; }
    const size_t kstep = (size_t)(BK * 2);
    const size_t hstepA = (size_t)HALF * lda * 2, hstepB = (size_t)HALF * K * 2;
    const unsigned ldsw = (unsigned)wid * 1024u;
    const int aoff = lds_byte(wr * 64 + fr, fq * 8), boff = lds_byte(wc * 32 + fr, fq * 8);
#define PG8_SA(b, h) (((b) * 2 + (h)) * HTB)
#define PG8_SB(b, h) ((4 + (b) * 2 + (h)) * HTB)
#define PG8_STAGE_B(bufoff, gbase, h) do { _Pragma("unroll") for (int _i = 0; _i < 2; ++_i) \
        __builtin_amdgcn_global_load_lds((const unsigned*)((const char*)(gbase) + (h) * hstepB + voffB[_i]), (LAS unsigned*)(lds + (bufoff) + ldsw + _i * 8192), 16, 0, 0); } while (0)
#define PG8_STAGE_A(bufoff, gbase, h, og) do { _Pragma("unroll") for (int _i = 0; _i < 2; ++_i) { \
        if constexpr (GATHER) __builtin_amdgcn_global_load_lds((const unsigned*)((const char*)(gbase) + (og)[h][_i]), (LAS unsigned*)(lds + (bufoff) + ldsw + _i * 8192), 16, 0, 0); \
        else __builtin_amdgcn_global_load_lds((const unsigned*)((const char*)(gbase) + (h) * hstepA + voffA[_i]), (LAS unsigned*)(lds + (bufoff) + ldsw + _i * 8192), 16, 0, 0); } } while (0)
#define PG8_LDA(dst, b, h) do { _Pragma("unroll") for (int m = 0; m < 4; ++m) _Pragma("unroll") for (int k = 0; k < 2; ++k) dst[m][k] = *(const LAS bf16x8*)(lds + PG8_SA(b, h) + aoff + m * 2048 + k * 1024); } while (0)
#define PG8_LDB(dst, b, h) do { _Pragma("unroll") for (int n = 0; n < 2; ++n) _Pragma("unroll") for (int k = 0; k < 2; ++k) dst[n][k] = *(const LAS bf16x8*)(lds + PG8_SB(b, h) + boff + n * 2048 + k * 1024); } while (0)
#define PG8_MMA(ai, bj, At, Bt) do { __builtin_amdgcn_s_setprio(1); _Pragma("unroll") for (int m = 0; m < 4; ++m) _Pragma("unroll") for (int n = 0; n < 2; ++n) { \
        if constexpr (FP8) { const i32x8 a8 = __builtin_shufflevector(__builtin_bit_cast(i32x4, At[m][0]), __builtin_bit_cast(i32x4, At[m][1]), 0, 1, 2, 3, 4, 5, 6, 7); \
            const i32x8 b8 = __builtin_shufflevector(__builtin_bit_cast(i32x4, Bt[n][0]), __builtin_bit_cast(i32x4, Bt[n][1]), 0, 1, 2, 3, 4, 5, 6, 7); \
            asm volatile("v_mfma_f32_16x16x128_f8f6f4 %0, %1, %2, %0" : "+v"(acc[ai][bj][m][n]) : "v"(b8), "v"(a8)); } \
        else { _Pragma("unroll") for (int k = 0; k < 2; ++k) acc[ai][bj][m][n] = __builtin_amdgcn_mfma_f32_16x16x32_bf16(Bt[n][k], At[m][k], acc[ai][bj][m][n], 0, 0, 0); } } \
        __builtin_amdgcn_s_setprio(0); } while (0)
#define PG8_MMA0(ai, bj, At, Bt) do { __builtin_amdgcn_s_setprio(1); _Pragma("unroll") for (int m = 0; m < 4; ++m) _Pragma("unroll") for (int n = 0; n < 2; ++n) { \
        if constexpr (FP8) { const i32x8 a8 = __builtin_shufflevector(__builtin_bit_cast(i32x4, At[m][0]), __builtin_bit_cast(i32x4, At[m][1]), 0, 1, 2, 3, 4, 5, 6, 7); \
            const i32x8 b8 = __builtin_shufflevector(__builtin_bit_cast(i32x4, Bt[n][0]), __builtin_bit_cast(i32x4, Bt[n][1]), 0, 1, 2, 3, 4, 5, 6, 7); \
            asm volatile("v_mfma_f32_16x16x128_f8f6f4 %0, %1, %2, 0" : "=&v"(acc[ai][bj][m][n]) : "v"(b8), "v"(a8)); } \
        else { acc[ai][bj][m][n] = __builtin_amdgcn_mfma_f32_16x16x32_bf16(Bt[n][0], At[m][0], (f32x4){0.f, 0.f, 0.f, 0.f}, 0, 0, 0); \
               acc[ai][bj][m][n] = __builtin_amdgcn_mfma_f32_16x16x32_bf16(Bt[n][1], At[m][1], acc[ai][bj][m][n], 0, 0, 0); } } \
        __builtin_amdgcn_s_setprio(0); } while (0)
#define PG8_WAIT_V(n) asm volatile("s_waitcnt vmcnt(" #n ")" ::: "memory")
#define PG8_WAIT_L(n) asm volatile("s_waitcnt lgkmcnt(" #n ")" ::: "memory")
#define PG8_BAR __builtin_amdgcn_s_barrier()
#define PG8_SCHED __builtin_amdgcn_sched_barrier(0)
    Unit cur, nxt; int ui = 0;
    if (!S.next(0, cur)) return;
    f32x4 acc[2][2][4][2];
#define PG8_ZERO_ACC do { _Pragma("unroll") for (int a = 0; a < 2; ++a) _Pragma("unroll") for (int b = 0; b < 2; ++b) _Pragma("unroll") for (int m = 0; m < 4; ++m) _Pragma("unroll") for (int n = 0; n < 2; ++n) \
        acc[a][b][m][n] = (f32x4){0.f, 0.f, 0.f, 0.f}; } while (0)
    bf16x8 At[4][2], B0[2][2], B1[2][2];
    unsigned ogc[2][2] = {{0u, 0u}, {0u, 0u}}, ogn[2][2] = {{0u, 0u}, {0u, 0u}};
    LAS unsigned char* const meta = lds + META_OFF;
#define PG8_META_DMA(u, slot) do { if (wid < 4) { const int r_ = tid < (u).nrows ? tid : (u).nrows - 1; const size_t ix_ = (size_t)(u).e * LCAP + (u).r0 + r_; \
            __builtin_amdgcn_global_load_lds((const unsigned*)(S.lflat + ix_), (LAS unsigned*)(meta + (slot) * META_SLOT + wid * 256), 4, 0, 0); \
            __builtin_amdgcn_global_load_lds((const unsigned*)(S.lval + ix_), (LAS unsigned*)(meta + (slot) * META_SLOT + 1024 + wid * 256), 4, 0, 0); } \
        else if (wid == 4) __builtin_amdgcn_global_load_lds((const unsigned*)(S.bias_ptr(u) + 4 * lane), (LAS unsigned*)(meta + (slot) * META_SLOT + 2048), 16, 0, 0); } while (0)
#define PG8_META_OG(dst, slot) do { _Pragma("unroll") for (int h = 0; h < 2; ++h) _Pragma("unroll") for (int i = 0; i < 2; ++i) \
        dst[h][i] = (unsigned)(((const LAS int*)(meta + (slot) * META_SLOT))[h * HALF + RA[i]] >> 2) * (unsigned)(K * 2) + (unsigned)CA[i] * 2u; } while (0)
    int ms_cur = 0, ms_nxt = 1;
    if constexpr (META) { PG8_META_DMA(cur, 0); asm volatile("s_waitcnt vmcnt(0)" ::: "memory"); __builtin_amdgcn_s_barrier(); asm volatile("" ::: "memory");
        if constexpr (GATHER) PG8_META_OG(ogc, 0); }
    else if constexpr (GATHER) {
#pragma unroll
        for (int h = 0; h < 2; ++h)
#pragma unroll
            for (int i = 0; i < 2; ++i) ogc[h][i] = S.row_off(cur, h * HALF + RA[i]) + (unsigned)CA[i] * 2u;
    }
    const int ktm = nt - 1;
#define PG8_KOFF(k, rot) ((size_t)(((k) + (rot)) & ktm) * kstep)
    int rot_c = 0; if constexpr (KROT) rot_c = S.krot(cur, nt);
    const char* cA = S.a_base(cur); const char* cB = S.b_base(cur);
    PG8_STAGE_B(PG8_SB(0, 0), cB + PG8_KOFF(0, rot_c), 0); PG8_STAGE_B(PG8_SB(0, 1), cB + PG8_KOFF(0, rot_c), 1); PG8_STAGE_A(PG8_SA(0, 0), cA + PG8_KOFF(0, rot_c), 0, ogc); PG8_STAGE_A(PG8_SA(0, 1), cA + PG8_KOFF(0, rot_c), 1, ogc);
    if (wr == 1) PG8_BAR;
    PG8_WAIT_V(2); PG8_BAR;
    PG8_STAGE_B(PG8_SB(1, 0), cB + PG8_KOFF(1, rot_c), 0); PG8_STAGE_A(PG8_SA(1, 0), cA + PG8_KOFF(1, rot_c), 0, ogc); PG8_STAGE_B(PG8_SB(1, 1), cB + PG8_KOFF(1, rot_c), 1);
    PG8_WAIT_V(6); PG8_BAR;
    for (;;) {
        const bool has_next = S.next(ui + 1, nxt);
        const char* nA = has_next ? S.a_base(nxt) : cA; const char* nB = has_next ? S.b_base(nxt) : cB;
        int rot_n = rot_c; if constexpr (KROT) { if (has_next) rot_n = S.krot(nxt, nt); }
        if constexpr (META) { if (has_next) PG8_META_DMA(nxt, ms_nxt); }
        else if constexpr (GATHER) {
#pragma unroll
            for (int h = 0; h < 2; ++h)
#pragma unroll
                for (int i = 0; i < 2; ++i) ogn[h][i] = has_next ? S.row_off(nxt, h * HALF + RA[i]) + (unsigned)CA[i] * 2u : ogc[h][i];
        }
#define PG8_PAIR(MM0) do { \
            const bool last = (t == nt - 2); \
            if constexpr (META && GATHER) { if (t == nt - 4) { if (has_next) PG8_META_OG(ogn, ms_nxt); else { \
                    _Pragma("unroll") for (int h = 0; h < 2; ++h) _Pragma("unroll") for (int i = 0; i < 2; ++i) ogn[h][i] = ogc[h][i]; } } } \
            const char* a1 = cA + PG8_KOFF(t + 1, rot_c); \
            const char* a2 = last ? nA + PG8_KOFF(0, rot_n) : cA + PG8_KOFF(t + 2, rot_c); const char* b2 = last ? nB + PG8_KOFF(0, rot_n) : cB + PG8_KOFF(t + 2, rot_c); \
            const char* a3 = a2 + kstep; const char* b3 = b2 + kstep;            \
            unsigned og2[2][2]; \
            _Pragma("unroll") for (int h = 0; h < 2; ++h) _Pragma("unroll") for (int i = 0; i < 2; ++i) og2[h][i] = last ? ogn[h][i] : ogc[h][i]; \
              \
            PG8_LDB(B0, 0, 0); PG8_LDB(B1, 0, 1); PG8_SCHED; PG8_LDA(At, 0, 0); PG8_STAGE_A(PG8_SA(1, 1), a1, 1, ogc); \
            PG8_WAIT_V(8); PG8_WAIT_L(0); PG8_BAR; MM0(0, 0, At, B0); MM0(0, 1, At, B1); PG8_BAR; PG8_SCHED; \
              \
            PG8_LDA(At, 0, 1); PG8_STAGE_B(PG8_SB(0, 0), b2, 0); PG8_STAGE_B(PG8_SB(0, 1), b2, 1); PG8_STAGE_A(PG8_SA(0, 0), a2, 0, og2); \
            PG8_WAIT_V(8); PG8_WAIT_L(0); PG8_BAR; MM0(1, 0, At, B0); MM0(1, 1, At, B1); PG8_BAR; PG8_SCHED; \
              \
            PG8_LDB(B0, 1, 0); PG8_LDB(B1, 1, 1); PG8_SCHED; PG8_LDA(At, 1, 0); PG8_STAGE_A(PG8_SA(0, 1), a2, 1, og2); \
            PG8_WAIT_V(8); PG8_WAIT_L(0); PG8_BAR; PG8_MMA(0, 0, At, B0); PG8_MMA(0, 1, At, B1); PG8_BAR; PG8_SCHED; \
              \
            PG8_LDA(At, 1, 1); PG8_STAGE_B(PG8_SB(1, 0), b3, 0); PG8_STAGE_B(PG8_SB(1, 1), b3, 1); PG8_STAGE_A(PG8_SA(1, 0), a3, 0, og2); \
            PG8_WAIT_V(8); PG8_WAIT_L(0); PG8_BAR; PG8_MMA(1, 0, At, B0); PG8_MMA(1, 1, At, B1); PG8_BAR; PG8_SCHED; } while (0)
        if constexpr (FP8) { { const int t = 0; PG8_PAIR(PG8_MMA0); } for (int t = 2; t < nt; t += 2) PG8_PAIR(PG8_MMA); }
        else { PG8_ZERO_ACC; for (int t = 0; t < nt; t += 2) PG8_PAIR(PG8_MMA); }
#undef PG8_PAIR
        if (wr == 0) PG8_BAR;
        if constexpr (FP8) asm volatile("s_nop 15\n\ts_nop 15" ::: "memory");
        E(acc, cur, wr, wc, fr, fq, (const LAS unsigned char*)(meta + ms_cur * META_SLOT));
        if (!has_next) break;
        ms_cur = ms_nxt; ms_nxt = (ms_nxt == 2) ? 0 : ms_nxt + 1;
        cur = nxt; cA = nA; cB = nB; ++ui; rot_c = rot_n;
        if constexpr (GATHER) {
#pragma unroll
            for (int h = 0; h < 2; ++h)
#pragma unroll
                for (int i = 0; i < 2; ++i) ogc[h][i] = ogn[h][i];
        }
        if (wr == 1) PG8_BAR;
    }
    PG8_WAIT_V(0);
    PG8_BAR;
#undef PG8_KOFF
#undef PG8_META_DMA
#undef PG8_META_OG
#undef PG8_SA
#undef PG8_SB
#undef PG8_STAGE_A
#undef PG8_STAGE_B
#undef PG8_LDA
#undef PG8_LDB
#undef PG8_MMA
#undef PG8_WAIT_V
#undef PG8_WAIT_L
#undef PG8_BAR
#undef PG8_SCHED
}

template <bool FP8_> struct DenseOrderT {
    static constexpr bool GATHER = false, FP8 = FP8_, META = false, KROT = (KROT_DENSE != 0);
    __device__ __forceinline__ int krot(const Unit& u, int nt) const { return (((u.pm & 7) + 2 * (u.pn & 3)) & 7) * (nt >> 3); }
    const char* A; const char* Bt; int lda, K; int nM, nN, nwg, G, c;
    __device__ __forceinline__ void init(const void* A_, const void* Bt_, int lda_, int K_, int M, int N, int G_, int c_) { A = (const char*)A_; Bt = (const char*)Bt_; lda = lda_; K = K_; nM = M / BM; nN = N / BM; nwg = nM * nN; G = G_; c = c_; }
    __device__ __forceinline__ bool next(int i, Unit& u) const {
        const long L = (long)i * G + c; if (L >= nwg) return false;
        int wgid = (int)L; { const int q = nwg / NXCD, r = nwg % NXCD, xcd = wgid % NXCD, off = wgid / NXCD; wgid = (xcd < r ? xcd * (q + 1) : r * (q + 1) + (xcd - r) * q) + off; }
        const int nig = WGM * nN, gid = wgid / nig, fm = gid * WGM, gsz = (nM - fm) < WGM ? (nM - fm) : WGM;
        u.pm = fm + ((wgid % nig) % gsz); u.pn = (wgid % nig) / gsz; u.e = 0; u.r0 = 0; u.nrows = 256; u.rb = u.pm; return true;
    }
    __device__ __forceinline__ const char* a_base(const Unit& u) const { return A + (size_t)u.pm * BM * lda * 2; }
    __device__ __forceinline__ const char* b_base(const Unit& u) const { return Bt + (size_t)u.pn * BM * K * 2; }
    __device__ __forceinline__ unsigned row_off(const Unit&, int) const { return 0u; }
};
typedef DenseOrderT<false> DenseOrder;
struct PoolOrder {
    static constexpr bool GATHER = false, FP8 = false, META = false, KROT = false;
    const char* A; const char* Bt; int lda, K; int G, c;
    __device__ __forceinline__ bool next(int i, Unit& u) const { const int L = i * G + c; if (L >= 512) return false; u.pm = L >> 2; u.pn = L & 3; u.e = 0; u.r0 = 0; u.nrows = 256; u.rb = u.pm; return true; }
    __device__ __forceinline__ const char* a_base(const Unit& u) const { return A + ((size_t)u.pm * BM * 1024 + (size_t)u.pn * 256) * 2; }
    __device__ __forceinline__ const char* b_base(const Unit& u) const { return Bt + (size_t)u.pn * 256 * 256 * 2; }
    __device__ __forceinline__ unsigned row_off(const Unit&, int) const { return 0u; }
};
template <int NT, bool GATHER_>
struct MoeOrder {
    static constexpr bool GATHER = GATHER_, FP8 = true, META = true, KROT = (KROT_MOE != 0) && !GATHER_;
    __device__ __forceinline__ int krot(const Unit& u, int nt) const { return (((u.rb & 7) + 2 * (u.pn & 3)) & 7) * (nt >> 3); }
    const char* A; const char* Bt; int lda, K; int G, c; const LAS int* tab; const int* lflat; const float* lval; const float* bias;
    __device__ __forceinline__ const float* bias_ptr(const Unit& u) const { return bias + (size_t)u.e * (NT * 256) + u.pn * 256; }
    __device__ __forceinline__ bool next(int i, Unit& u) const {
        const int nblk = tab[32];
        const int L = i * G + c; int rb, pn;
        if (G == 256) { const int rd = L >> 8, cc = L & 255, xcd = cc & 7, j = cc >> 3;
            if (NT == 16) { rb = rd * 16 + (xcd & 1) * 8 + (j & 7); pn = (xcd >> 1) * 4 + (j >> 3); } else { rb = rd * 32 + xcd * 4 + (j & 3); pn = j >> 2; } }
        else { rb = L / NT; pn = L % NT; }
        if (rb >= nblk) return false;
        int ln = (int)(threadIdx.x & 63); asm volatile("" : "+v"(ln));     const int tv = tab[ln < 32 ? ln : ln + 8];
        const int e = __builtin_popcountll(__builtin_amdgcn_ballot_w64(ln < 32 && tv <= rb)) - 1;
        const int r0 = (rb - __builtin_amdgcn_readlane(tv, e)) * 256; int nr = __builtin_amdgcn_readlane(tv, 32 + e) - r0; nr = nr > 256 ? 256 : nr;
        u.pm = rb; u.pn = pn; u.e = e; u.r0 = r0; u.nrows = nr; u.rb = rb; return true;
    }
    __device__ __forceinline__ const char* a_base(const Unit& u) const { return GATHER ? A : A + (size_t)u.rb * BM * lda * 2; }
    __device__ __forceinline__ const char* b_base(const Unit& u) const { return Bt + ((size_t)u.e * (NT * 256) + (size_t)u.pn * 256) * K * 2; }
    __device__ __forceinline__ unsigned row_off(const Unit& u, int r) const { const int fl = lflat[u.e * LCAP + u.r0 + ((r < u.nrows) ? r : 0)]; return (unsigned)(fl >> 2) * (unsigned)(K * 2); }
};

#define EPI_ROWS(ai, m) (ai * HALF + wr * 64 + m * 16 + fr)
struct EpiInProj {
    bf16* U; bf16* Q; bf16* Kb; const float* qg; const float* kg;
    __device__ __forceinline__ void operator()(const f32x4 (&acc)[2][2][4][2], const Unit& u, int wr, int wc, int fr, int fq, const LAS unsigned char* ms) const {
        const int row0 = u.pm * BM;
        if (u.pn < 4) {
            const int col0 = u.pn * BM + wc * 32 + 8 * fq;
#pragma unroll
            for (int ai = 0; ai < 2; ++ai)
#pragma unroll
                for (int m = 0; m < 4; ++m) { bf16* rowp = U + (size_t)(row0 + EPI_ROWS(ai, m)) * POOLW + col0;
#pragma unroll
                    for (int bj = 0; bj < 2; ++bj) { const f32x4 v0 = acc[ai][bj][m][0], v1 = acc[ai][bj][m][1];
                        u32x4 w; w.x = cvt_pk_bf16(v0[0], v0[1]); w.y = cvt_pk_bf16(v0[2], v0[3]); w.z = cvt_pk_bf16(v1[0], v1[1]); w.w = cvt_pk_bf16(v1[2], v1[3]);
                        *(u32x4*)(rowp + bj * HALF) = w; } }
        } else {
            const bool isq = u.pn < 8; const int tile = isq ? u.pn - 4 : u.pn - 8; bf16* O = isq ? Q : Kb; const float* g = isq ? qg : kg; const float sc = isq ? 0.125f * LOG2E : 1.0f;
            const int head = tile * 4 + wc;
            f32x4 gv[2][2];
#pragma unroll
            for (int bj = 0; bj < 2; ++bj)
#pragma unroll
                for (int n = 0; n < 2; ++n) gv[bj][n] = *(const f32x4*)(g + 32 * bj + 8 * fq + 4 * n) * sc;
#pragma unroll
            for (int ai = 0; ai < 2; ++ai)
#pragma unroll
                for (int m = 0; m < 4; ++m) {
                    float ss = 0.f;
#pragma unroll
                    for (int bj = 0; bj < 2; ++bj)
#pragma unroll
                        for (int n = 0; n < 2; ++n) { const f32x4 v = acc[ai][bj][m][n]; ss += (v[0] * v[0] + v[1] * v[1]) + (v[2] * v[2] + v[3] * v[3]); }
                    ss += __shfl_xor(ss, 16); ss += __shfl_xor(ss, 32);
                    const float rstd = __builtin_amdgcn_rsqf(ss * (1.0f / 64.0f) + EPS);
                    bf16* rowp = O + (size_t)(row0 + EPI_ROWS(ai, m)) * 1024 + head * 64 + 8 * fq;
#pragma unroll
                    for (int bj = 0; bj < 2; ++bj) { const f32x4 v0 = acc[ai][bj][m][0] * rstd * gv[bj][0], v1 = acc[ai][bj][m][1] * rstd * gv[bj][1];
                        u32x4 w; w.x = cvt_pk_bf16(v0[0], v0[1]); w.y = cvt_pk_bf16(v0[2], v0[3]); w.z = cvt_pk_bf16(v1[0], v1[1]); w.w = cvt_pk_bf16(v1[2], v1[3]);
                        *(u32x4*)(rowp + 32 * bj) = w; }
                }
        }
    }
};
struct EpiPlain {
    bf16* O; int ldc; const float* scale; int colmul;
    __device__ __forceinline__ void operator()(const f32x4 (&acc)[2][2][4][2], const Unit& u, int wr, int wc, int fr, int fq, const LAS unsigned char* ms) const {
        const int row0 = u.pm * BM, col0 = u.pn * BM + wc * 32 + 8 * fq;
        f32x4 sv[2][2];
#pragma unroll
        for (int bj = 0; bj < 2; ++bj)
#pragma unroll
            for (int n = 0; n < 2; ++n) sv[bj][n] = scale ? *(const f32x4*)(scale + col0 + bj * HALF + 4 * n) : (f32x4){1.f, 1.f, 1.f, 1.f};
#pragma unroll
        for (int ai = 0; ai < 2; ++ai)
#pragma unroll
            for (int m = 0; m < 4; ++m) { bf16* rowp = O + (size_t)(row0 + EPI_ROWS(ai, m)) * ldc + col0;
#pragma unroll
                for (int bj = 0; bj < 2; ++bj) { const f32x4 v0 = acc[ai][bj][m][0] * sv[bj][0], v1 = acc[ai][bj][m][1] * sv[bj][1];
                    u32x4 w; w.x = cvt_pk_bf16(v0[0], v0[1]); w.y = cvt_pk_bf16(v0[2], v0[3]); w.z = cvt_pk_bf16(v1[0], v1[1]); w.w = cvt_pk_bf16(v1[2], v1[3]);
                    *(u32x4*)(rowp + bj * HALF) = w; } }
    }
};
struct EpiE {
    bf16* O; float* sse;
    __device__ __forceinline__ void operator()(const f32x4 (&acc)[2][2][4][2], const Unit& u, int wr, int wc, int fr, int fq, const LAS unsigned char* ms) const {
        const int row0 = u.pm * BM, col0 = u.pn * BM + wc * 32 + 8 * fq;
#pragma unroll
        for (int ai = 0; ai < 2; ++ai)
#pragma unroll
            for (int m = 0; m < 4; ++m) { const int row = row0 + EPI_ROWS(ai, m); bf16* rowp = O + (size_t)row * DM + col0; float ss = 0.f;
#pragma unroll
                for (int bj = 0; bj < 2; ++bj) { const f32x4 v0 = acc[ai][bj][m][0], v1 = acc[ai][bj][m][1];
                    ss += (v0[0] * v0[0] + v0[1] * v0[1]) + (v0[2] * v0[2] + v0[3] * v0[3]) + (v1[0] * v1[0] + v1[1] * v1[1]) + (v1[2] * v1[2] + v1[3] * v1[3]);
                    u32x4 w; w.x = cvt_pk_bf16(v0[0], v0[1]); w.y = cvt_pk_bf16(v0[2], v0[3]); w.z = cvt_pk_bf16(v1[0], v1[1]); w.w = cvt_pk_bf16(v1[2], v1[3]);
                    *(u32x4*)(rowp + bj * HALF) = w; }
                ss += __shfl_xor(ss, 16); ss += __shfl_xor(ss, 32);
                if (fq == 0) sse[(size_t)row * 32 + u.pn * 4 + wc] = ss; }
    }
};
struct EpiWout {
    const float* x; bf16* H1; unsigned char* XG; const float* g;
    __device__ __forceinline__ void operator()(const f32x4 (&acc)[2][2][4][2], const Unit& u, int wr, int wc, int fr, int fq, const LAS unsigned char* ms) const {
        const int row0 = u.pm * BM, col0 = u.pn * BM + wc * 32 + 8 * fq;
        f32x4 gv[2][2];
#pragma unroll
        for (int bj = 0; bj < 2; ++bj)
#pragma unroll
            for (int n = 0; n < 2; ++n) gv[bj][n] = *(const f32x4*)(g + col0 + bj * HALF + 4 * n) * SC_X8;
#pragma unroll
        for (int am = 0; am < 4; ++am) { const int ai = am >> 1;
            f32x4 xv[2][2][2];
#pragma unroll
            for (int mm = 0; mm < 2; ++mm) { const int m = 2 * (am & 1) + mm; const size_t off = (size_t)(row0 + EPI_ROWS(ai, m)) * DM + col0;
#pragma unroll
                for (int bj = 0; bj < 2; ++bj) { xv[mm][bj][0] = *(const f32x4*)(x + off + bj * HALF); xv[mm][bj][1] = *(const f32x4*)(x + off + bj * HALF + 4); } }
#pragma unroll
            for (int mm = 0; mm < 2; ++mm) { const int m = 2 * (am & 1) + mm; const size_t off = (size_t)(row0 + EPI_ROWS(ai, m)) * DM + col0;
#pragma unroll
                for (int bj = 0; bj < 2; ++bj) { const f32x4 h0 = xv[mm][bj][0] + acc[ai][bj][m][0], h1 = xv[mm][bj][1] + acc[ai][bj][m][1];
                    { u32x4 hw; hw.x = cvt_pk_bf16(h0[0], h0[1]); hw.y = cvt_pk_bf16(h0[2], h0[3]); hw.z = cvt_pk_bf16(h1[0], h1[1]); hw.w = cvt_pk_bf16(h1[2], h1[3]); *(u32x4*)(H1 + off + bj * HALF) = hw; }
                    const f32x4 v0 = h0 * gv[bj][0], v1 = h1 * gv[bj][1];
                    u32x2 w; w.x = pk4_fp8(v0[0], v0[1], v0[2], v0[3]); w.y = pk4_fp8(v1[0], v1[1], v1[2], v1[3]);
                    *(u32x2*)(XG + off + bj * HALF) = w; } }
            asm volatile("" ::: "memory"); }
    }
};
struct EpiGU {
    unsigned char* ACT;
    __device__ __forceinline__ void operator()(const f32x4 (&acc)[2][2][4][2], const Unit& u, int wr, int wc, int fr, int fq, const LAS unsigned char* ms) const {
        const int q = 4 * wc + fq;
        const LAS float* mval = (const LAS float*)(ms + 1024); const LAS float* mbias = (const LAS float*)(ms + 2048);
        f32x2 bg[2][2], bu[2][2];
#pragma unroll
        for (int bj = 0; bj < 2; ++bj)
#pragma unroll
            for (int n = 0; n < 2; ++n) { const f32x4 b = *(const LAS f32x4*)(mbias + 16 * q + 8 * bj + 4 * n); bg[bj][n] = (f32x2){b[0], b[2]}; bu[bj][n] = (f32x2){b[1], b[3]}; }
        u32x2 wv[2]; const unsigned lane_off = (unsigned)((wr * 64 + fr + 16 * (fq & 1)) * FF + 8 * (q & ~1));
#pragma unroll
        for (int ai = 0; ai < 2; ++ai)
#pragma unroll
            for (int m = 0; m < 4; ++m) { const int r = EPI_ROWS(ai, m); const bool valid = r < u.nrows; const float rs = valid ? mval[r] * (1.0f / (SC_X8 * SC_W8)) : 0.f;
                f32x2 o[4];
#pragma unroll
                for (int bj = 0; bj < 2; ++bj)
#pragma unroll
                    for (int n = 0; n < 2; ++n) { const f32x4 a = acc[ai][bj][m][n];
                        f32x2 g = (f32x2){a[0], a[1]} * rs + bg[bj][n], up = (f32x2){a[2], a[3]} * rs + bu[bj][n];
                        g = (f32x2){__builtin_fminf(g[0], 7.0f), __builtin_fminf(g[1], 7.0f)};
                        up = (f32x2){__builtin_amdgcn_fmed3f(up[0], -7.0f, 7.0f), __builtin_amdgcn_fmed3f(up[1], -7.0f, 7.0f)};
                        const f32x2 xa = g * (-1.702f * LOG2E);
                        const f32x2 d = (f32x2){__builtin_amdgcn_exp2f(xa[0]), __builtin_amdgcn_exp2f(xa[1])} + 1.0f;
                        const f32x2 t = g * (f32x2){__builtin_amdgcn_rcpf(d[0]), __builtin_amdgcn_rcpf(d[1])};
                        o[2 * bj + n] = t * (up * SC_A8 + SC_A8); }
                wv[m & 1].x = pk4_fp8_nc(o[0][0], o[0][1], o[1][0], o[1][1]); wv[m & 1].y = pk4_fp8_nc(o[2][0], o[2][1], o[3][0], o[3][1]);
                if (m & 1)
                    *(u32x4*)(ACT + ((size_t)(u.rb * BM + ai * HALF + (m - 1) * 16) * FF + u.pn * HALF) + lane_off) = pair16(wv[0], wv[1]); }
    }
};
struct EpiDown {
    unsigned char* Y4;
    __device__ __forceinline__ void operator()(const f32x4 (&acc)[2][2][4][2], const Unit& u, int wr, int wc, int fr, int fq, const LAS unsigned char* ms) const {
        const int col0 = u.pn * BM + wc * 32 + 8 * fq;
        const LAS int* mflat = (const LAS int*)ms; const LAS float* mval = (const LAS float*)(ms + 1024); const LAS float* mbias = (const LAS float*)(ms + 2048);
        f32x4 bv[2][2];
#pragma unroll
        for (int bj = 0; bj < 2; ++bj)
#pragma unroll
            for (int n = 0; n < 2; ++n) bv[bj][n] = *(const LAS f32x4*)(mbias + wc * 32 + 8 * fq + bj * HALF + 4 * n);
#pragma unroll
        for (int ai = 0; ai < 2; ++ai)
#pragma unroll
            for (int m = 0; m < 4; ++m) { const int r = EPI_ROWS(ai, m); const bool valid = r < u.nrows;
                const float gt = mval[r]; const int fl = mflat[r];
                unsigned char* rowp = Y4 + (size_t)fl * DM + col0 + ((fq & 1) ? (HALF - 8) : 0); const float gs = gt * SC_Y8;
                u32x2 w[2];
#pragma unroll
                for (int bj = 0; bj < 2; ++bj) { const f32x4 v0 = (acc[ai][bj][m][0] * (1.0f / (SC_A8 * SC_W8)) + bv[bj][0]) * gs, v1 = (acc[ai][bj][m][1] * (1.0f / (SC_A8 * SC_W8)) + bv[bj][1]) * gs;
                    w[bj].x = pk4_fp8(v0[0], v0[1], v0[2], v0[3]); w[bj].y = pk4_fp8(v1[0], v1[1], v1[2], v1[3]); }
                const u32x4 o = pair16(w[0], w[1]);
                if (valid) *(u32x4*)rowp = o; }
    }
};
struct EpiGate {
    const bf16* H2; const bf16* ER; const float* rstde; const float* gn; float* out;
    __device__ __forceinline__ void operator()(const f32x4 (&acc)[2][2][4][2], const Unit& u, int wr, int wc, int fr, int fq, const LAS unsigned char* ms) const {
        const int row0 = u.pm * BM, col0 = u.pn * BM + wc * 32 + 8 * fq;
        f32x4 gv[2][2];
#pragma unroll
        for (int bj = 0; bj < 2; ++bj)
#pragma unroll
            for (int n = 0; n < 2; ++n) gv[bj][n] = *(const f32x4*)(gn + col0 + bj * HALF + 4 * n);
#pragma unroll
        for (int am = 0; am < 4; ++am) { const int ai = am >> 1;
            u32x4 hv[2][2], ev[2][2]; float rsv[2];
#pragma unroll
            for (int mm = 0; mm < 2; ++mm) { const int m = 2 * (am & 1) + mm; const int row = row0 + EPI_ROWS(ai, m); const size_t off = (size_t)row * DM + col0; rsv[mm] = rstde[row];
#pragma unroll
                for (int bj = 0; bj < 2; ++bj) { hv[mm][bj] = *(const u32x4*)(H2 + off + bj * HALF); ev[mm][bj] = *(const u32x4*)(ER + off + bj * HALF); } }
#pragma unroll
            for (int mm = 0; mm < 2; ++mm) { const int m = 2 * (am & 1) + mm; const int row = row0 + EPI_ROWS(ai, m); const size_t off = (size_t)row * DM + col0; const float rs = rsv[mm];
#pragma unroll
                for (int bj = 0; bj < 2; ++bj) { const u32x4 hh = hv[mm][bj], er = ev[mm][bj];
                    const f32x4 h0 = {bf_lo(hh.x), bf_hi(hh.x), bf_lo(hh.y), bf_hi(hh.y)}, h1 = {bf_lo(hh.z), bf_hi(hh.z), bf_lo(hh.w), bf_hi(hh.w)};
                    const f32x4 e0 = (f32x4){bf_lo(er.x), bf_hi(er.x), bf_lo(er.y), bf_hi(er.y)} * rs * gv[bj][0], e1 = (f32x4){bf_lo(er.z), bf_hi(er.z), bf_lo(er.w), bf_hi(er.w)} * rs * gv[bj][1];
                    const f32x4 a0 = acc[ai][bj][m][0] * (1.0f / (SC_G8 * SC_W8)), a1 = acc[ai][bj][m][1] * (1.0f / (SC_G8 * SC_W8));
                    f32x4 o0, o1;
#pragma unroll
                    for (int j = 0; j < 4; ++j) { o0[j] = h0[j] + fast_sigmoid(a0[j]) * e0[j]; o1[j] = h1[j] + fast_sigmoid(a1[j]) * e1[j]; }
                    *(f32x4*)(out + off + bj * HALF) = o0; *(f32x4*)(out + off + bj * HALF + 4) = o1; } }
            asm volatile("" ::: "memory"); }
    }
};
#undef EPI_ROWS
}

#define XB_TMO      128
#define XB_XCNT(j)  (256  + 64 * (j))
#define XB_XSUB(j)  (1280 + 64 * (j))
#define XB_XGEN(j)  (2304 + 64 * (j))
#define XB_TOP      3328
#define XB_TOPGEN   3392
#define XCD_BAR_WORDS 3456
#define XB_SPIN_CAP (1u << 18)
__device__ __forceinline__ unsigned xb_ld(unsigned* p)              { return __hip_atomic_load(p, __ATOMIC_RELAXED, __HIP_MEMORY_SCOPE_AGENT); }
__device__ __forceinline__ unsigned xb_add(unsigned* p, unsigned v) { return __hip_atomic_fetch_add(p, v, __ATOMIC_RELAXED, __HIP_MEMORY_SCOPE_AGENT); }
__device__ __forceinline__ unsigned xb_xcc_id() { return (unsigned)__builtin_amdgcn_s_getreg((3 << 11) | 20) & 0xFu; }
#define XB_SPIN(cond, bar) do { unsigned _sp = 0; while (cond) { __builtin_amdgcn_s_sleep(1); \
    if ((++_sp & 255u) == 0u) { if (xb_ld(&(bar)[XB_TMO])) break; if (_sp > XB_SPIN_CAP) { atomicAdd(&(bar)[XB_TMO], 1u); break; } } } } while (0)
struct XcdBarrier { unsigned* bar; unsigned x; volatile LAS unsigned* st; };
__device__ __forceinline__ XcdBarrier xcd_barrier_post(unsigned* bar, volatile LAS unsigned* st) {
    XcdBarrier b; b.bar = bar; b.x = xb_xcc_id(); b.st = st;
    if (threadIdx.x == 0) (void)xb_add(&bar[XB_XCNT(b.x)], 1u);
    return b;
}
__device__ __forceinline__ void xcd_barrier_complete(unsigned* bar, unsigned x, unsigned& nloc, unsigned& nx) {
    const unsigned G = gridDim.x * gridDim.y * gridDim.z;
    unsigned sum, cnt, mine, sp = 0u;
    for (;;) {
        sum = 0u; cnt = 0u; mine = 0u;
#pragma unroll
        for (unsigned j = 0; j < 16; ++j) { const unsigned c = xb_ld(&bar[XB_XCNT(j)]); sum += c; cnt += (c > 0u) ? 1u : 0u; mine = (j == x) ? c : mine; }
        if (sum == G) break;
        __builtin_amdgcn_s_sleep(1);
        if ((++sp & 255u) == 0u) { if (xb_ld(&bar[XB_TMO])) break; if (sp > XB_SPIN_CAP) { atomicAdd(&bar[XB_TMO], 1u); break; } }
    }
    nloc = mine > 0u ? mine : 1u; nx = cnt > 0u ? cnt : 1u;
}
__device__ __forceinline__ void xcd_barrier(const XcdBarrier& b) {
    asm volatile("s_waitcnt vmcnt(0)" ::: "memory");
    __syncthreads();
    if (threadIdx.x == 0) {
        unsigned* bar = b.bar;
        __builtin_amdgcn_s_waitcnt(0);
        unsigned nloc = b.st[0], nx = b.st[1];
        if (nloc == 0u) { xcd_barrier_complete(bar, b.x, nloc, nx); b.st[0] = nloc; b.st[1] = nx; }
        const unsigned old = xb_add(&bar[XB_XSUB(b.x)], 1u);
        const unsigned gen = old / nloc;
        if (old + 1u == (gen + 1u) * nloc) {
            __builtin_amdgcn_fence(__ATOMIC_RELEASE, "agent");
            asm volatile("s_waitcnt vmcnt(0)" ::: "memory");
            const unsigned og = xb_add(&bar[XB_TOP], 1u);
            const unsigned tg = og / nx;
            if (og + 1u == (tg + 1u) * nx) xb_add(&bar[XB_TOPGEN], 1u);
            else XB_SPIN(xb_ld(&bar[XB_TOPGEN]) == tg, bar);
            __builtin_amdgcn_fence(__ATOMIC_ACQUIRE, "agent");
            xb_add(&bar[XB_XGEN(b.x)], 1u);
            asm volatile("s_waitcnt vmcnt(0)" ::: "memory");
        } else {
            XB_SPIN(xb_ld(&bar[XB_XGEN(b.x)]) == gen, bar);
            __builtin_amdgcn_fence(__ATOMIC_ACQUIRE, "agent");
            asm volatile("s_waitcnt vmcnt(0)" ::: "memory");
        }
    }
    __syncthreads();
}

__device__ __forceinline__ unsigned f2bf(float f) { unsigned u = __builtin_bit_cast(unsigned, f); return (u + 0x7fffu + ((u >> 16) & 1u)) >> 16; }
__device__ __forceinline__ unsigned pk2(float lo, float hi) { return f2bf(lo) | (f2bf(hi) << 16); }
__device__ __forceinline__ void tr_item(const float* W, int N, bf16* dstrow0, int K, int k0, int n0, LAS float* scr, int lane) {
    { float v_[32]; const float* wp_ = W + (size_t)(k0 + (lane >> 5)) * N + n0 + (lane & 31);
#pragma unroll
      for (int i = 0; i < 32; ++i) v_[i] = wp_[(size_t)(2 * i) * N];
#pragma unroll
      for (int i = 0; i < 32; ++i) scr[(2 * i + (lane >> 5)) * 33 + (lane & 31)] = v_[i]; }
    asm volatile("s_waitcnt lgkmcnt(0)" ::: "memory");
    const int c = lane & 7;
#pragma unroll
    for (int j = 0; j < 4; ++j) { const int n = (lane >> 3) + 8 * j; const LAS float* s = scr + (8 * c) * 33 + n;
        u32x4 o; o.x = pk2(s[0 * 33], s[1 * 33]); o.y = pk2(s[2 * 33], s[3 * 33]); o.z = pk2(s[4 * 33], s[5 * 33]); o.w = pk2(s[6 * 33], s[7 * 33]);
        *(u32x4*)(dstrow0 + (size_t)n * K + k0 + 8 * c) = o; }
    asm volatile("s_waitcnt lgkmcnt(0)" ::: "memory");
}

template <class RowMap>
__device__ __forceinline__ void tr_item_fp8(const float* W, int N, unsigned char* dst, int Kb, int k0, int n0, float scale, const RowMap& rowmap, LAS float* scr, int lane) {
    { float v_[32]; const float* wp_ = W + (size_t)(k0 + (lane >> 5)) * N + n0 + (lane & 31);
#pragma unroll
      for (int i = 0; i < 32; ++i) v_[i] = wp_[(size_t)(2 * i) * N];
#pragma unroll
      for (int i = 0; i < 32; ++i) scr[(2 * i + (lane >> 5)) * 33 + (lane & 31)] = v_[i]; }
    asm volatile("s_waitcnt lgkmcnt(0)" ::: "memory");
    const int n = lane >> 1, hf = lane & 1; const LAS float* sp = scr + (32 * hf) * 33 + n;
    u32x4 o0, o1;
    o0.x = pk4_fp8(sp[0 * 33] * scale, sp[1 * 33] * scale, sp[2 * 33] * scale, sp[3 * 33] * scale);     o0.y = pk4_fp8(sp[4 * 33] * scale, sp[5 * 33] * scale, sp[6 * 33] * scale, sp[7 * 33] * scale);
    o0.z = pk4_fp8(sp[8 * 33] * scale, sp[9 * 33] * scale, sp[10 * 33] * scale, sp[11 * 33] * scale);   o0.w = pk4_fp8(sp[12 * 33] * scale, sp[13 * 33] * scale, sp[14 * 33] * scale, sp[15 * 33] * scale);
    o1.x = pk4_fp8(sp[16 * 33] * scale, sp[17 * 33] * scale, sp[18 * 33] * scale, sp[19 * 33] * scale); o1.y = pk4_fp8(sp[20 * 33] * scale, sp[21 * 33] * scale, sp[22 * 33] * scale, sp[23 * 33] * scale);
    o1.z = pk4_fp8(sp[24 * 33] * scale, sp[25 * 33] * scale, sp[26 * 33] * scale, sp[27 * 33] * scale); o1.w = pk4_fp8(sp[28 * 33] * scale, sp[29 * 33] * scale, sp[30 * 33] * scale, sp[31 * 33] * scale);
    unsigned char* d = dst + (size_t)rowmap(n) * Kb + k0 + 32 * hf;
    *(u32x4*)d = o0; *(u32x4*)(d + 16) = o1;
    asm volatile("s_waitcnt lgkmcnt(0)" ::: "memory");
}

template <bool GUPERM>
__device__ __forceinline__ void conv_task2(const float* W, int N, unsigned char* dst, int k0, int n0, int lane) {
    const float* src = W + (size_t)k0 * N + n0 + lane;
    const int n = n0 + lane; int row = n;
    if (GUPERM) { const int hl = n & 255, q = hl >> 4, i16 = hl & 15; row = (n & ~255) + 128 * (i16 >> 3) + 32 * (q >> 2) + 8 * (q & 3) + (i16 & 4) + ((i16 & 1) << 1) + ((i16 >> 1) & 1); }
    unsigned char* d = dst + (size_t)row * 2048 + k0;
#pragma unroll
    for (int hf = 0; hf < 2; ++hf) { float v[64];
#pragma unroll
        for (int k = 0; k < 64; ++k) v[k] = src[(size_t)(64 * hf + k) * N];
#pragma unroll
        for (int c = 0; c < 4; ++c) { u32x4 o;
            o.x = pk4_fp8(v[16 * c + 0] * SC_W8, v[16 * c + 1] * SC_W8, v[16 * c + 2] * SC_W8, v[16 * c + 3] * SC_W8);   o.y = pk4_fp8(v[16 * c + 4] * SC_W8, v[16 * c + 5] * SC_W8, v[16 * c + 6] * SC_W8, v[16 * c + 7] * SC_W8);
            o.z = pk4_fp8(v[16 * c + 8] * SC_W8, v[16 * c + 9] * SC_W8, v[16 * c + 10] * SC_W8, v[16 * c + 11] * SC_W8); o.w = pk4_fp8(v[16 * c + 12] * SC_W8, v[16 * c + 13] * SC_W8, v[16 * c + 14] * SC_W8, v[16 * c + 15] * SC_W8);
            *(u32x4*)(d + 64 * hf + 16 * c) = o; } }
}

struct Args { const float* in[20]; float* out; unsigned char* ws; int ph_lo, ph_hi; };

__device__ __forceinline__ int crow(int r, int hi) { return (r & 3) + 8 * (r >> 2) + 4 * hi; }
__device__ __forceinline__ void attn_block_scores(const bf16x8 (&kf)[4], const bf16x8 (&qf)[4], const bf16x8 (&tri)[2], bool diag, int r32, int hi, float& carry, u32x4& p0, u32x4& p1) {
    f32x16 z = {};
#pragma unroll
    for (int ks = 0; ks < 4; ++ks) z = __builtin_amdgcn_mfma_f32_32x32x16_bf16(kf[ks], qf[ks], z, 0, 0, 0);
#pragma unroll
    for (int r = 0; r < 16; ++r) z[r] = (diag && crow(r, hi) >= r32) ? -1.0e30f : z[r];
    float lk[16]; float tot = 0.f;
#pragma unroll
    for (int r = 0; r < 16; ++r) { const float e = __builtin_amdgcn_exp2f(-__builtin_fabsf(z[r])); const float sp = __builtin_fmaxf(z[r], 0.f) + __builtin_amdgcn_logf(1.0f + e);
        lk[r] = -sp; z[r] = z[r] - sp; tot -= sp; }
    u32x4 l0, l1; l0.x = cvtpk(lk[0], lk[1]); l0.y = cvtpk(lk[2], lk[3]); l0.z = cvtpk(lk[4], lk[5]); l0.w = cvtpk(lk[6], lk[7]);
    l1.x = cvtpk(lk[8], lk[9]); l1.y = cvtpk(lk[10], lk[11]); l1.z = cvtpk(lk[12], lk[13]); l1.w = cvtpk(lk[14], lk[15]);
    f32x16 lp = {};
    lp = __builtin_amdgcn_mfma_f32_32x32x16_bf16(tri[0], __builtin_bit_cast(bf16x8, l0), lp, 0, 0, 0);
    lp = __builtin_amdgcn_mfma_f32_32x32x16_bf16(tri[1], __builtin_bit_cast(bf16x8, l1), lp, 0, 0, 0);
    { auto rr = __builtin_amdgcn_permlane32_swap(__float_as_uint(tot), __float_as_uint(tot), false, false); tot = __uint_as_float(rr[0]) + __uint_as_float(rr[1]); }
    float p[16];
#pragma unroll
    for (int r = 0; r < 16; ++r) p[r] = __builtin_amdgcn_exp2f(z[r] + carry + lp[r]);
    carry += tot;
    p0.x = cvtpk(p[0], p[1]); p0.y = cvtpk(p[2], p[3]); p0.z = cvtpk(p[4], p[5]); p0.w = cvtpk(p[6], p[7]);
    p1.x = cvtpk(p[8], p[9]); p1.y = cvtpk(p[10], p[11]); p1.z = cvtpk(p[12], p[13]); p1.w = cvtpk(p[14], p[15]);
}
__device__ __forceinline__ void attn_wave_pair(LAS unsigned char* lw, const bf16* Q, const bf16* Kg, const bf16* VT, bf16* MIX, int b, int h, int jp, const bf16x8 (&tri)[2]) {
    const int lane = threadIdx.x & 63, r32 = lane & 31, hi = lane >> 5;
    const int jA = 2 * jp + 1, jB = 2 * jp;
    unsigned koff[4];
#pragma unroll
    for (int i_ = 0; i_ < 4; ++i_) { const int rs_ = lane >> 3, key_ = (i_ << 2) | (rs_ >> 1) | ((rs_ & 1) << 4), c_ = (lane & 7) ^ (key_ & 7); koff[i_] = (unsigned)(key_ * 1024 + c_ * 8); }
    const bf16* ksrc = Kg + (size_t)b * SEQ * 1024 + h * 64;
    const int kfb = ((r32 >> 2) & 3) * 1024 + ((((r32 & 3) << 1) | (r32 >> 4)) * 128);
    const bf16* vsrc = VT + ((size_t)h * 64 + (lane >> 2)) * T + (size_t)b * SEQ + (((lane & 3) ^ ((lane >> 4) & 3)) * 8);
#define ATT_DMA(kb, buf) do { _Pragma("unroll") for (int i_ = 0; i_ < 4; ++i_) { \
        __builtin_amdgcn_global_load_lds((const unsigned*)(ksrc + (size_t)(kb) * 32 * 1024 + koff[i_]), (LAS unsigned*)(lw + (buf) * 8192 + i_ * 1024), 16, 0, 0); \
        __builtin_amdgcn_global_load_lds((const unsigned*)(vsrc + (size_t)(kb) * 32 + (size_t)(16 * i_) * T), (LAS unsigned*)(lw + (buf) * 8192 + 4096 + i_ * 1024), 16, 0, 0); } } while (0)
    ATT_DMA(jA, 0);
    bf16x8 qfA[4], qfB[4];
#pragma unroll
    for (int ks = 0; ks < 4; ++ks) { qfA[ks] = *(const bf16x8*)(Q + ((size_t)b * SEQ + 32 * jA + r32) * 1024 + h * 64 + 16 * ks + 8 * hi);
                                     qfB[ks] = *(const bf16x8*)(Q + ((size_t)b * SEQ + 32 * jB + r32) * 1024 + h * 64 + 16 * ks + 8 * hi); }
    f32x16 oA0 = {}, oA1 = {}, oB0 = {}, oB1 = {};
    float carryA = 0.f, carryB = 0.f; bool liveA = true, liveB = true;
    int cur = 0;
    for (int kb = jA; kb >= 0; --kb) {
        if (kb > 0) { ATT_DMA(kb - 1, cur ^ 1); asm volatile("s_waitcnt vmcnt(8)" ::: "memory"); }
        else asm volatile("s_waitcnt vmcnt(0)" ::: "memory");
        const LAS unsigned char* Kb = lw + cur * 8192; const LAS unsigned char* Vb = Kb + 4096;
        bf16x8 kf[4];
#pragma unroll
        for (int ks = 0; ks < 4; ++ks) kf[ks] = *(const LAS bf16x8*)(Kb + kfb + (((2 * ks + hi) ^ (r32 & 7)) * 16));
        const bool doA = liveA, doB = liveB && (kb <= jB);
#define ATT_STEP(DA, DB) do { u32x4 pA0, pA1, pB0, pB1; \
            if (DA) attn_block_scores(kf, qfA, tri, kb == jA, r32, hi, carryA, pA0, pA1); \
            if (DB) attn_block_scores(kf, qfB, tri, kb == jB, r32, hi, carryB, pB0, pB1); \
            _Pragma("unroll") for (int ks = 0; ks < 2; ++ks) { _Pragma("unroll") for (int db = 0; db < 2; ++db) { const int d_ = 32 * db + r32, sw_ = (d_ >> 2) & 3; const LAS unsigned char* vp = Vb + d_ * 64 + 8 * hi; \
                const u32x2 lo = *(const LAS u32x2*)(vp + (((2 * ks) ^ sw_) * 16)), hh = *(const LAS u32x2*)(vp + (((2 * ks + 1) ^ sw_) * 16)); const u32x4 vv = {lo.x, lo.y, hh.x, hh.y}; const bf16x8 vf = __builtin_bit_cast(bf16x8, vv); \
                if (DA) { const bf16x8 pb = __builtin_bit_cast(bf16x8, ks ? pA1 : pA0); if (db == 0) oA0 = __builtin_amdgcn_mfma_f32_32x32x16_bf16(vf, pb, oA0, 0, 0, 0); else oA1 = __builtin_amdgcn_mfma_f32_32x32x16_bf16(vf, pb, oA1, 0, 0, 0); } \
                if (DB) { const bf16x8 pb = __builtin_bit_cast(bf16x8, ks ? pB1 : pB0); if (db == 0) oB0 = __builtin_amdgcn_mfma_f32_32x32x16_bf16(vf, pb, oB0, 0, 0, 0); else oB1 = __builtin_amdgcn_mfma_f32_32x32x16_bf16(vf, pb, oB1, 0, 0, 0); } } } } while (0)
        if (doA && doB) ATT_STEP(true, true);
        else if (doA) ATT_STEP(true, false);
        else if (doB) ATT_STEP(false, true);
#undef ATT_STEP
        asm volatile("s_waitcnt lgkmcnt(0)" ::: "memory");
        cur ^= 1;
        if (doA && __builtin_amdgcn_ballot_w64(carryA > -150.0f) == 0ull) liveA = false;
        if (doB && __builtin_amdgcn_ballot_w64(carryB > -150.0f) == 0ull) liveB = false;
        if (!liveA && !liveB) break;
    }
    asm volatile("s_waitcnt vmcnt(0)" ::: "memory");
#pragma unroll
    for (int sub = 0; sub < 2; ++sub) { const f32x16& o0 = sub ? oB0 : oA0; const f32x16& o1 = sub ? oB1 : oA1;
        bf16* orow8 = MIX + ((size_t)b * SEQ + 32 * (sub ? jB : jA) + r32) * DM + POOLW + h * 64 + 8 * hi;
#pragma unroll
        for (int gp = 0; gp < 2; ++gp) {
#pragma unroll
            for (int hf = 0; hf < 2; ++hf) { const f32x16& o = hf ? o1 : o0; const int g0 = 2 * gp, g1 = 2 * gp + 1;
                const unsigned a0 = cvtpk(o[4 * g0], o[4 * g0 + 1]), a1 = cvtpk(o[4 * g0 + 2], o[4 * g0 + 3]), b0 = cvtpk(o[4 * g1], o[4 * g1 + 1]), b1 = cvtpk(o[4 * g1 + 2], o[4 * g1 + 3]);
                const auto s0 = __builtin_amdgcn_permlane32_swap(a0, b0, false, false); const auto s1 = __builtin_amdgcn_permlane32_swap(a1, b1, false, false);
                u32x4 w; w.x = s0[0]; w.y = s1[0]; w.z = s0[1]; w.w = s1[1];
                *(u32x4*)(orow8 + 32 * hf + 16 * gp) = w; } } }
#undef ATT_DMA
}

constexpr int NWAVES = 8;
__global__ void __launch_bounds__(NWAVES * 64, 2) fwd(Args args) {
    extern __shared__ __attribute__((aligned(16))) unsigned char lds_raw[];
    LAS unsigned char* lds = (LAS unsigned char*)lds_raw;
    volatile LAS unsigned* MISC = (volatile LAS unsigned*)(lds + MISC_OFF);
    const int tid = threadIdx.x, lane = tid & 63, wave = __builtin_amdgcn_readfirstlane(tid >> 6);
    const int G = gridDim.x, bx = blockIdx.x;
    unsigned char* ws = args.ws;
    unsigned* ctl = (unsigned*)(ws + WS_CTL);
    const float* x = args.in[0]; const float* pin = args.in[1]; const float* ln_mix_g = args.in[2]; const float* w_in = args.in[3]; const float* pool_w = args.in[4]; const float* pool_scale = args.in[5];
    const float* q_norm_g = args.in[6]; const float* k_norm_g = args.in[7]; const float* w_out = args.in[8]; const float* ln_ffn_g = args.in[9]; const float* router_w = args.in[10]; const float* router_b = args.in[11];
    const float* w_gate_up = args.in[12]; const float* b_gate_up = args.in[13]; const float* w_down = args.in[14]; const float* b_down = args.in[15]; const float* ln_ple_g = args.in[16];
    const float* ple_gate_w = args.in[17]; const float* ple_proj = args.in[18]; const float* ple_norm_g = args.in[19];
    bf16* WinT = (bf16*)(ws + WS_WINT); bf16* WvT = (bf16*)(ws + WS_WVT); bf16* PoolT = (bf16*)(ws + WS_POOLT); bf16* WRhi = (bf16*)(ws + WS_WRHI); bf16* WRlo = (bf16*)(ws + WS_WRLO);
    bf16* WoutT = (bf16*)(ws + WS_WOUTT); unsigned char* Wgate8 = ws + WS_WGATET; bf16* WprojT = (bf16*)(ws + WS_WPROJT); bf16* Pbf = (bf16*)(ws + WS_PBF);
    int* LFLAT = (int*)(ws + WS_LFLAT); float* LGATE = (float*)(ws + WS_LGATE); float* LRSTD = (float*)(ws + WS_LRSTD); float* SSE = (float*)(ws + WS_SSE); float* RSTDE = (float*)(ws + WS_RSTDE);
    bf16* HN = (bf16*)(ws + WS_HN); bf16* Ub = (bf16*)(ws + WS_U); bf16* Qb = (bf16*)(ws + WS_Q); bf16* Kb = (bf16*)(ws + WS_K); bf16* VT = (bf16*)(ws + WS_VT); bf16* DD = (bf16*)(ws + WS_DD);
    bf16* MIX = (bf16*)(ws + WS_MIX); bf16* H1 = (bf16*)(ws + WS_H1); unsigned char* XG2 = ws + WS_XG2; bf16* ERAW = (bf16*)(ws + WS_ERAW); unsigned char* Wgu8 = ws + WS_WGUT; unsigned char* Wd8 = ws + WS_WDT;
    unsigned char* ACT = ws + WS_ACT; unsigned char* Y4 = ws + WS_Y4; unsigned char* XG3 = ws + WS_HN; bf16* H2b = (bf16*)(ws + WS_XG2);

    for (int u = tid; u < (LDS_BYTES - LDSCTL_OFF) / 4; u += NWAVES * 64) ((LAS unsigned*)(lds + LDSCTL_OFF))[u] = 0u;
    __syncthreads();
    XcdBarrier bar; bar.bar = ctl + CW_BAR; bar.x = 0; bar.st = nullptr;
    if (MK_ONE_LAUNCH) bar = xcd_barrier_post(ctl + CW_BAR, MISC + 8);
    const int lo = args.ph_lo, hi = args.ph_hi;
#ifndef DUP_PHASE
#define DUP_PHASE -1
#endif
#define REP(k) for (int rep_ = 0; rep_ < ((DUP_PHASE == (k)) ? 2 : 1); ++rep_)
#ifndef PHASE_MASK
#define PHASE_MASK 0x3ff
#endif
#define IN(k) (((PHASE_MASK >> (k)) & 1) && lo <= (k) && (k) < hi)
#define SEAM(k) do { if (IN(k) && IN((k) + 1)) xcd_barrier(bar); } while (0)
    const int gw = bx * NWAVES + wave, NGW = G * NWAVES;
    const int gt = bx * (NWAVES * 64) + tid, NGT = G * NWAVES * 64;

    if (IN(0)) REP(0) {
        LAS float* scr = (LAS float*)(lds + wave * 16384);
        constexpr int I_IN = 32 * 128, I_POOL = 4 * 4 * 8, I_OUT = 32 * 64, I_GATE = 32 * 64, I_PROJ = 4 * 64;
        constexpr int NITEMS = I_IN + I_POOL + I_OUT + I_GATE + I_PROJ;
        for (int it = gw; it < NITEMS; it += NGW) {
            int r = it;
            if (r < I_IN) { const int kb = r / 128, nb = r % 128, n0 = nb * 32; bf16* dst;
                if (n0 < 1024) dst = WinT + (size_t)n0 * DM;
                else if (n0 < 3072) { const int part = (n0 - 1024) / 1024, nn = (n0 - 1024) % 1024, head = nn >> 6, d0 = nn & 63, tile = head >> 2, hl = head & 3;
                    dst = WinT + ((size_t)1024 + part * 1024 + tile * 256 + 128 * (d0 >> 5) + 32 * hl) * DM; }
                else dst = WvT + (size_t)(n0 - 3072) * DM;
                tr_item(w_in, 4096, dst, DM, kb * 64, n0, scr, lane); continue; } r -= I_IN;
            if (r < I_POOL) { const int g = r / 32, q = r % 32, kb = q / 8, nb = q % 8;
                tr_item(pool_w + (size_t)g * 65536, 256, PoolT + ((size_t)g * 256 + nb * 32) * 256, 256, kb * 64, nb * 32, scr, lane); continue; } r -= I_POOL;
            if (r < I_OUT) { const int kb = r / 64, nb = r % 64; tr_item(w_out, DM, WoutT + (size_t)nb * 32 * DM, DM, kb * 64, nb * 32, scr, lane); continue; } r -= I_OUT;
            if (r < I_GATE) { const int kb = r / 64, nb = r % 64, n0 = nb * 32; auto rm = [n0](int nn) { return n0 + nn; };
                tr_item_fp8(ple_gate_w, DM, Wgate8, DM, kb * 64, n0, SC_W8, rm, scr, lane); continue; } r -= I_GATE;
            { const int kb = r / 64, nb = r % 64; tr_item(ple_proj, DM, WprojT + (size_t)nb * 32 * PLE, PLE, kb * 64, nb * 32, scr, lane); }
        }
        for (int i = gt; i < NE * DM; i += NGT) { const int e = i / DM, k = i % DM; const float w = router_w[k * NE + e] * ln_ffn_g[k];
            const unsigned h16 = f2bf(w); const float hf = __uint_as_float(h16 << 16); WRhi[i] = (bf16)h16; WRlo[i] = (bf16)f2bf(w - hf); }
        for (int i = gt; i < T * PLE / 8; i += NGT) { const f32x4 a = *(const f32x4*)(pin + (size_t)i * 8), b = *(const f32x4*)(pin + (size_t)i * 8 + 4);
            u32x4 w; w.x = pk2(a[0], a[1]); w.y = pk2(a[2], a[3]); w.z = pk2(b[0], b[1]); w.w = pk2(b[2], b[3]); *(u32x4*)(Pbf + (size_t)i * 8) = w; }
        { f32x4 gm[4][2];
#pragma unroll
          for (int j = 0; j < 4; ++j) { gm[j][0] = *(const f32x4*)(ln_mix_g + 8 * lane + 512 * j); gm[j][1] = *(const f32x4*)(ln_mix_g + 8 * lane + 512 * j + 4); }
          for (int m = gw; m < T; m += NGW) { const float* xr = x + (size_t)m * DM + 8 * lane; f32x4 v[4][2]; float s = 0.f;
#pragma unroll
            for (int j = 0; j < 4; ++j) { v[j][0] = *(const f32x4*)(xr + 512 * j); v[j][1] = *(const f32x4*)(xr + 512 * j + 4);
                s += ((v[j][0][0] * v[j][0][0] + v[j][0][1] * v[j][0][1]) + (v[j][0][2] * v[j][0][2] + v[j][0][3] * v[j][0][3])) + ((v[j][1][0] * v[j][1][0] + v[j][1][1] * v[j][1][1]) + (v[j][1][2] * v[j][1][2] + v[j][1][3] * v[j][1][3])); }
            const float rstd = 1.0f / sqrtf(wave_sum(s) * (1.0f / DM) + EPS);
            bf16* op = HN + (size_t)m * DM + 8 * lane;
#pragma unroll
            for (int j = 0; j < 4; ++j) { const f32x4 a = v[j][0] * rstd * gm[j][0], b = v[j][1] * rstd * gm[j][1]; u32x4 w; w.x = pk2(a[0], a[1]); w.y = pk2(a[2], a[3]); w.z = pk2(b[0], b[1]); w.w = pk2(b[2], b[3]);
                *(u32x4*)(op + 512 * j) = w; } } }
        __syncthreads();
    }
    SEAM(0);

#define CONV_RANGE(i_lo, i_hi) do { for (int ci_ = (i_lo); ci_ < (i_hi); ++ci_) { const int tk = gw + NGW * ci_; if (tk < 32768 + 16384) { \
        if (tk < 32768) { const int e = tk >> 10, rem = tk & 1023, kb = rem >> 6, nb = rem & 63; conv_task2<true>(w_gate_up + (size_t)e * DM * 4096, 4096, Wgu8 + (size_t)e * 4096 * DM, kb * 128, nb * 64, lane); } \
        else { const int t2 = tk - 32768, e = t2 >> 9, rem = t2 & 511, kb = rem >> 5, nb = rem & 31; conv_task2<false>(w_down + (size_t)e * FF * DM, DM, Wd8 + (size_t)e * DM * FF, kb * 128, nb * 64, lane); } } } } while (0)
    if (IN(1)) {
        const int conv_n = (32768 + 16384 + NGW - 1) / NGW, conv_n1 = (conv_n * (bx & 7)) >> 3;
        CONV_RANGE(0, conv_n1);
        REP(10) { pg8::DenseOrder S; S.init(HN, WinT, DM, DM, T, 3072, G, bx); pg8::EpiInProj E{Ub, Qb, Kb, q_norm_g, k_norm_g}; pg8::gemm_phase(lds, S, E); }
        __syncthreads();
        REP(11) { pg8::DenseOrder S; S.init(WvT, HN, DM, DM, 1024, T, G, bx); pg8::EpiPlain E{VT, T, nullptr, 0}; pg8::gemm_phase(lds, S, E); }
        __syncthreads();
        CONV_RANGE(conv_n1, conv_n);
    }
    SEAM(1);

    if (IN(2)) REP(2) {
        { bf16x8 tri[2];
#pragma unroll
          for (int ks = 0; ks < 2; ++ks)
#pragma unroll
              for (int i = 0; i < 8; ++i) tri[ks][i] = (crow(8 * ks + i, lane >> 5) > (lane & 31)) ? (short)0x3F80 : (short)0;
          LAS unsigned char* lw = lds + wave * 16384;
          REP(20) for (int u = gw; u < BATCH * NH * (SEQ / 64); u += NGW) { const int bh = u >> 5, jp = 31 - (u & 31); attn_wave_pair(lw, Qb, Kb, VT, MIX, bh / NH, bh % NH, jp, tri); } }
#define POOL_ACC(S_, q_, sg_) do { S_[0] += (sg_) * bf_lo((q_).x); S_[1] += (sg_) * bf_hi((q_).x); S_[2] += (sg_) * bf_lo((q_).y); S_[3] += (sg_) * bf_hi((q_).y); \
        S_[4] += (sg_) * bf_lo((q_).z); S_[5] += (sg_) * bf_hi((q_).z); S_[6] += (sg_) * bf_lo((q_).w); S_[7] += (sg_) * bf_hi((q_).w); } while (0)
#define POOL_OUT(i_, cur_) do { const int n_ = (s0 + (i_) + 1 < W_) ? s0 + (i_) + 1 : W_; const float inv = 1.0f / (float)n_; u32x4 o; \
        o.x = pk2(S[0] * inv - bf_lo((cur_).x), S[1] * inv - bf_hi((cur_).x)); o.y = pk2(S[2] * inv - bf_lo((cur_).y), S[3] * inv - bf_hi((cur_).y)); \
        o.z = pk2(S[4] * inv - bf_lo((cur_).z), S[5] * inv - bf_hi((cur_).z)); o.w = pk2(S[6] * inv - bf_lo((cur_).w), S[7] * inv - bf_hi((cur_).w)); \
        *(u32x4*)(DD + (size_t)(tok0 + (i_)) * POOLW + c8 * 8) = o; } while (0)
#define POOL_GROUP(g_) do { constexpr int W_ = 2 << (g_); constexpr int NT_ = 8, NR_ = W_ + NT_ - 1; \
        for (int it = gt; it < (T / NT_) * 32; it += NGT) { const int tok0 = (it >> 5) * NT_, c8 = (g_) * 32 + (it & 31), s0 = tok0 & (SEQ - 1); \
            const bf16* up = Ub + (size_t)(tok0 + NT_ - 1) * POOLW + c8 * 8; u32x4 q[NR_];            \
            _Pragma("unroll") for (int k = 0; k < NR_; ++k) { const bool ok = (s0 + NT_ - 1 - k) >= 0; const u32x4 ld = *(const u32x4*)(up - (size_t)(ok ? k : 0) * POOLW); \
                q[k].x = ok ? ld.x : 0u; q[k].y = ok ? ld.y : 0u; q[k].z = ok ? ld.z : 0u; q[k].w = ok ? ld.w : 0u; } \
            float S[8] = {0.f, 0.f, 0.f, 0.f, 0.f, 0.f, 0.f, 0.f}; \
            _Pragma("unroll") for (int k = 0; k < W_; ++k) POOL_ACC(S, q[k], 1.0f); \
            POOL_OUT(NT_ - 1, q[0]); \
            _Pragma("unroll") for (int i = NT_ - 2; i >= 0; --i) { POOL_ACC(S, q[NT_ - 2 - i], -1.0f); POOL_ACC(S, q[W_ + NT_ - 2 - i], 1.0f); POOL_OUT(i, q[NT_ - 1 - i]); } } } while (0)
        POOL_GROUP(0); POOL_GROUP(1); POOL_GROUP(2); POOL_GROUP(3);
#undef POOL_GROUP
#undef POOL_OUT
#undef POOL_ACC
        __syncthreads();
    }
    SEAM(2);

    if (IN(3)) REP(3) {
        { pg8::PoolOrder S{(const char*)DD, (const char*)PoolT, POOLW, 256, G, bx}; pg8::EpiPlain E{MIX, DM, pool_scale, 0}; pg8::gemm_phase(lds, S, E); }
        __syncthreads();
        { pg8::DenseOrder S; S.init(Pbf, WprojT, PLE, PLE, T, DM, G, bx); pg8::EpiE E{ERAW, SSE}; pg8::gemm_phase(lds, S, E); }
        __syncthreads();
    }
    SEAM(3);

    if (IN(4)) REP(4) {
        pg8::DenseOrder S; S.init(MIX, WoutT, DM, DM, T, DM, G, bx); pg8::EpiWout E{x, H1, XG2, ln_ffn_g}; pg8::gemm_phase(lds, S, E);
        __syncthreads();
    }
    SEAM(4);

    if (IN(5)) {
        LAS float* lg = (LAS float*)lds;
        LAS float* lrs = (LAS float*)(lds + 20480);
        LAS int* lcnt = (LAS int*)(lds + 21504);
        LAS int* lbase = (LAS int*)(lds + 21760);
        LAS int* ent_e = (LAS int*)(lds + 22528);
        LAS int* ent_rank = (LAS int*)(lds + 24576);
        LAS float* ent_gate = (LAS float*)(lds + 26624);
        for (int chunk = bx; chunk < T / 128; chunk += G) {
            const int tok0 = chunk * 128;
            if (tid < 32) lcnt[tid] = 0;
            __syncthreads();
            const int tl = lane & 15, kq = lane >> 4, tokn = tok0 + wave * 16 + tl;
            f32x4 a0 = {0.f, 0.f, 0.f, 0.f}, a1 = {0.f, 0.f, 0.f, 0.f}; float ss = 0.f;
            const bf16* xr = H1 + (size_t)tokn * DM + 8 * kq;
            LAS unsigned char* wbuf = lds + 32768; constexpr int WROW = 528, WMAT = 32 * WROW, WBUF = 2 * WMAT;
            u32x4 wreg[4];
#define RT_LOAD(c) do { _Pragma("unroll") for (int q_ = 0; q_ < 4; ++q_) { const int p_ = tid + 512 * q_, mat_ = p_ >> 10, e_ = (p_ >> 5) & 31, c16_ = p_ & 31; \
                wreg[q_] = *(const u32x4*)((mat_ ? WRlo : WRhi) + (size_t)e_ * DM + (c) * 256 + c16_ * 8); } } while (0)
#define RT_STORE(b) do { _Pragma("unroll") for (int q_ = 0; q_ < 4; ++q_) { const int p_ = tid + 512 * q_, mat_ = p_ >> 10, e_ = (p_ >> 5) & 31, c16_ = p_ & 31; \
                *(LAS u32x4*)(wbuf + (b) * WBUF + mat_ * WMAT + e_ * WROW + c16_ * 16) = wreg[q_]; } } while (0)
            RT_LOAD(0); RT_STORE(0); __syncthreads();
            for (int c = 0; c < 8; ++c) {
                if (c < 7) RT_LOAD(c + 1);
                const LAS unsigned char* wb = wbuf + (c & 1) * WBUF + tl * WROW + kq * 16;
#pragma unroll
                for (int s8 = 0; s8 < 8; ++s8) { const int ks = c * 8 + s8;
                    const u32x4 xh = *(const u32x4*)(xr + 32 * ks);
                    { const float f0 = bf_lo(xh.x), f1 = bf_hi(xh.x), f2 = bf_lo(xh.y), f3 = bf_hi(xh.y), f4 = bf_lo(xh.z), f5 = bf_hi(xh.z), f6 = bf_lo(xh.w), f7 = bf_hi(xh.w);
                      ss += (f0 * f0 + f1 * f1) + (f2 * f2 + f3 * f3) + (f4 * f4 + f5 * f5) + (f6 * f6 + f7 * f7); }
                    const bf16x8 bxh = __builtin_bit_cast(bf16x8, xh);
                    const bf16x8 ah0 = *(const LAS bf16x8*)(wb + s8 * 64), ah1 = *(const LAS bf16x8*)(wb + 16 * WROW + s8 * 64), al0 = *(const LAS bf16x8*)(wb + WMAT + s8 * 64), al1 = *(const LAS bf16x8*)(wb + WMAT + 16 * WROW + s8 * 64);
                    a0 = __builtin_amdgcn_mfma_f32_16x16x32_bf16(ah0, bxh, a0, 0, 0, 0); a0 = __builtin_amdgcn_mfma_f32_16x16x32_bf16(al0, bxh, a0, 0, 0, 0);
                    a1 = __builtin_amdgcn_mfma_f32_16x16x32_bf16(ah1, bxh, a1, 0, 0, 0); a1 = __builtin_amdgcn_mfma_f32_16x16x32_bf16(al1, bxh, a1, 0, 0, 0); }
                if (c < 7) RT_STORE((c + 1) & 1);
                __syncthreads();
            }
#undef RT_LOAD
#undef RT_STORE
            ss += __shfl_xor(ss, 16); ss += __shfl_xor(ss, 32);
            const float rstd = 1.0f / sqrtf(ss * (1.0f / DM) + EPS);
            LAS float* lgw = lg + (wave * 16 + tl) * 33;
#pragma unroll
            for (int j = 0; j < 4; ++j) { lgw[4 * kq + j] = a0[j] * rstd + router_b[4 * kq + j]; lgw[16 + 4 * kq + j] = a1[j] * rstd + router_b[16 + 4 * kq + j]; }
            if (kq == 0) lrs[wave * 16 + tl] = rstd;
            __syncthreads();
            if (tid < 128) {
                const LAS float* l = lg + tid * 33; float v[4]; int id[4]; unsigned used = 0u;
#pragma unroll
                for (int k = 0; k < 4; ++k) { float best = -3.0e38f; int bi = 0;
                    for (int e = 0; e < NE; ++e) { const float f = l[e]; const bool ok = !((used >> e) & 1u) && (f > best); best = ok ? f : best; bi = ok ? e : bi; }
                    v[k] = best; id[k] = bi; used |= 1u << bi; }
                const float e1 = __expf(v[1] - v[0]), e2 = __expf(v[2] - v[0]), e3 = __expf(v[3] - v[0]); const float inv = 1.0f / (1.0f + e1 + e2 + e3);
                const float gk[4] = {inv, e1 * inv, e2 * inv, e3 * inv};
#pragma unroll
                for (int k = 0; k < 4; ++k) { const int rk = atomicAdd((int*)(lcnt + id[k]), 1); ent_e[tid * 4 + k] = id[k]; ent_rank[tid * 4 + k] = rk; ent_gate[tid * 4 + k] = gk[k]; }
            }
            __syncthreads();
            if (tid < 32) lbase[tid] = (int)__hip_atomic_fetch_add(ctl + CW_CNT + tid, (unsigned)lcnt[tid], __ATOMIC_RELAXED, __HIP_MEMORY_SCOPE_AGENT);
            __syncthreads();
            { const int e = ent_e[tid], pos = lbase[e] + ent_rank[tid]; const size_t o = (size_t)e * LCAP + pos;
              LFLAT[o] = tok0 * 4 + tid; LGATE[o] = ent_gate[tid]; LRSTD[o] = lrs[tid >> 2]; }
            __syncthreads();
        }
    }
    SEAM(5);

    if (IN(6) || IN(7)) {
        LAS int* tab = (LAS int*)(lds + TAB_OFF);
        if (tid < 32) {
            const int c = (int)__hip_atomic_load(ctl + CW_CNT + tid, __ATOMIC_RELAXED, __HIP_MEMORY_SCOPE_AGENT); const int nb = (c + 255) >> 8; int incl = nb;
#pragma unroll
            for (int o = 1; o < 32; o <<= 1) { const int v = __shfl_up(incl, o, 32); incl += (tid >= o) ? v : 0; }
            tab[tid] = incl - nb; tab[40 + tid] = c; if (tid == 31) tab[32] = incl; }
        __syncthreads();
    }
    if (IN(6)) REP(6) {
        pg8::MoeOrder<16, true> S{(const char*)XG2, (const char*)Wgu8, DM / 2, DM / 2, G, bx, (const LAS int*)(lds + TAB_OFF), LFLAT, LRSTD, b_gate_up};
        pg8::EpiGU E{ACT}; pg8::gemm_phase(lds, S, E);
        __syncthreads();
    }
    SEAM(6);
    if (IN(7)) REP(7) {
        pg8::MoeOrder<8, false> S{(const char*)ACT, (const char*)Wd8, FF / 2, FF / 2, G, bx, (const LAS int*)(lds + TAB_OFF), LFLAT, LGATE, b_down};
        pg8::EpiDown E{Y4}; pg8::gemm_phase(lds, S, E);
        __syncthreads();
    }
    SEAM(7);

    if (IN(8)) REP(8) {
        f32x4 gq[2][4];
#pragma unroll
        for (int j = 0; j < 2; ++j)
#pragma unroll
            for (int q = 0; q < 4; ++q) gq[j][q] = *(const f32x4*)(ln_ple_g + 16 * lane + 1024 * j + 4 * q);
        for (int m = gw; m < T; m += NGW) { float v[2][16]; float s = 0.f;
#pragma unroll
            for (int j = 0; j < 2; ++j) { const bf16* hp = H1 + (size_t)m * DM + 16 * lane + 1024 * j; const u32x4 a = *(const u32x4*)hp, b = *(const u32x4*)(hp + 8);
                v[j][0] = bf_lo(a.x); v[j][1] = bf_hi(a.x); v[j][2] = bf_lo(a.y); v[j][3] = bf_hi(a.y); v[j][4] = bf_lo(a.z); v[j][5] = bf_hi(a.z); v[j][6] = bf_lo(a.w); v[j][7] = bf_hi(a.w);
                v[j][8] = bf_lo(b.x); v[j][9] = bf_hi(b.x); v[j][10] = bf_lo(b.y); v[j][11] = bf_hi(b.y); v[j][12] = bf_lo(b.z); v[j][13] = bf_hi(b.z); v[j][14] = bf_lo(b.w); v[j][15] = bf_hi(b.w); }
#pragma unroll
            for (int k = 0; k < 4; ++k)
#pragma unroll
                for (int j = 0; j < 2; ++j) { const u32x4 y = *(const u32x4*)(Y4 + ((size_t)m * 4 + k) * DM + 16 * lane + 1024 * j); const unsigned yd[4] = {y.x, y.y, y.z, y.w};
#pragma unroll
                    for (int d = 0; d < 4; ++d) { const f32x2 lo = __builtin_amdgcn_cvt_pk_f32_fp8(yd[d], false), hh = __builtin_amdgcn_cvt_pk_f32_fp8(yd[d], true);
                        v[j][4 * d] += lo[0] * (1.0f / SC_Y8); v[j][4 * d + 1] += lo[1] * (1.0f / SC_Y8); v[j][4 * d + 2] += hh[0] * (1.0f / SC_Y8); v[j][4 * d + 3] += hh[1] * (1.0f / SC_Y8); } }
#pragma unroll
            for (int j = 0; j < 2; ++j) { bf16* op = H2b + (size_t)m * DM + 16 * lane + 1024 * j; u32x4 w0, w1;
                w0.x = pk2(v[j][0], v[j][1]); w0.y = pk2(v[j][2], v[j][3]); w0.z = pk2(v[j][4], v[j][5]); w0.w = pk2(v[j][6], v[j][7]);
                w1.x = pk2(v[j][8], v[j][9]); w1.y = pk2(v[j][10], v[j][11]); w1.z = pk2(v[j][12], v[j][13]); w1.w = pk2(v[j][14], v[j][15]);
                *(u32x4*)op = w0; *(u32x4*)(op + 8) = w1;
#pragma unroll
                for (int c = 0; c < 16; ++c) s += v[j][c] * v[j][c]; }
            const float rstd = SC_G8 / sqrtf(wave_sum(s) * (1.0f / DM) + EPS);
#pragma unroll
            for (int j = 0; j < 2; ++j) { u32x4 o; unsigned od[4];
#pragma unroll
                for (int d = 0; d < 4; ++d) od[d] = pk4_fp8(v[j][4 * d] * rstd * gq[j][d][0], v[j][4 * d + 1] * rstd * gq[j][d][1], v[j][4 * d + 2] * rstd * gq[j][d][2], v[j][4 * d + 3] * rstd * gq[j][d][3]);
                o.x = od[0]; o.y = od[1]; o.z = od[2]; o.w = od[3]; *(u32x4*)(XG3 + (size_t)m * DM + 16 * lane + 1024 * j) = o; }
            const float se = wave_sum(lane < 32 ? SSE[(size_t)m * 32 + lane] : 0.f);
            if (lane == 0) RSTDE[m] = 1.0f / sqrtf(se * (1.0f / DM) + EPS); }
        __syncthreads();
    }
    SEAM(8);

    if (IN(9)) REP(9) {
        pg8::DenseOrderT<true> S; S.init(XG3, Wgate8, DM / 2, DM / 2, T, DM, G, bx); pg8::EpiGate E{H2b, ERAW, RSTDE, ple_norm_g, args.out}; pg8::gemm_phase(lds, S, E);
    }
#undef IN
#undef SEAM
}

extern "C" void kernel_launch(void* const* d_in, const int* in_sizes, int n_in, void* d_out, int out_size, void* d_ws, size_t ws_size, hipStream_t stream) {
    static int grid = 0;
    if (grid == 0) {
        if (n_in != 20 || out_size != T * DM || ws_size < WS_END) { fprintf(stderr, "kernel_launch: unexpected shapes (n_in %d, out %d, ws %zu < %zu)\n", n_in, out_size, ws_size, (size_t)WS_END); grid = -1; return; }
        int dev = 0, cus = 0, per_cu = 0;
        if (hipGetDevice(&dev) != hipSuccess || hipDeviceGetAttribute(&cus, hipDeviceAttributeMultiprocessorCount, dev) != hipSuccess) { grid = -1; return; }
        if (hipFuncSetAttribute((const void*)fwd, hipFuncAttributeMaxDynamicSharedMemorySize, LDS_BYTES) != hipSuccess) { fprintf(stderr, "kernel_launch: hipFuncSetAttribute failed\n"); grid = -1; return; }
        if (hipOccupancyMaxActiveBlocksPerMultiprocessor(&per_cu, (const void*)fwd, NWAVES * 64, LDS_BYTES) != hipSuccess || per_cu < 1) fprintf(stderr, "kernel_launch: occupancy query says %d\n", per_cu);
        (void)hipGetLastError();
        grid = cus;
    }
    if (grid < 0) return;
    (void)hipMemsetAsync((char*)d_ws + WS_CTL, 0, CTL_ZERO_BYTES, stream);
    Args a{};
    for (int i = 0; i < 20; ++i) a.in[i] = (const float*)d_in[i];
    a.out = (float*)d_out; a.ws = (unsigned char*)d_ws;
#if MK_ONE_LAUNCH
    a.ph_lo = 0; a.ph_hi = NPHASE;
    hipLaunchKernelGGL(fwd, dim3(grid), dim3(NWAVES * 64), LDS_BYTES, stream, a);
#else
    for (int p = 0; p < NPHASE; ++p) { a.ph_lo = p; a.ph_hi = p + 1; hipLaunchKernelGGL(fwd, dim3(grid), dim3(NWAVES * 64), LDS_BYTES, stream, a); }
#endif
}
```
